# Optimizing an MI355X kernel written in HIP

```python
import math
import jax, jax.numpy as jnp
from jax import lax
import numpy as np

D_MODEL = 2048
BATCH = 8
SEQ = 2048
DEPTH = 1

CHUNK = 64
N_META = 16
Q_BLOCK = 128
EPS = 1e-6

D_SSM = D_MODEL // 2
SSM_GROUP = 16
N_SSM_GROUPS = D_SSM // SSM_GROUP
SSM_STATE = 64
DT_MIN = 1e-3
DT_MAX = 1e-1

MLA_HEADS = 8
QK_NOPE = 128
QK_ROPE = 64
V_HEAD = 128
Q_LORA = 512
KV_LORA = 256
D_ATTN = MLA_HEADS * V_HEAD
ROPE_BASE = 10000.0

D_MIX = D_SSM + D_ATTN
D_IN = D_SSM + Q_LORA + KV_LORA + QK_ROPE

D_FF = 5504
CONV_W = 3

kernel_name = "hybrid_s5_mla_convffn_block"


def rmsnorm(x, g):
    xf = x.astype(jnp.float32)
    y = xf * lax.rsqrt(jnp.mean(xf * xf, axis=-1, keepdims=True) + EPS)
    return (y * g.astype(jnp.float32)).astype(x.dtype)


def rotary(x, cos, sin):
    x1, x2 = jnp.split(x, 2, axis=-1)
    return jnp.concatenate([x1 * cos - x2 * sin, x2 * cos + x1 * sin], axis=-1)


def s5_mixer(u, lam_re, lam_im, log_dt, b_re, b_im, c_re, c_im, d_skip, w_glu, b_glu):
    bsz, L, _ = u.shape
    f32 = jnp.float32
    uf = u.astype(f32).reshape(bsz, L, N_SSM_GROUPS, SSM_GROUP)
    lam = lax.complex(lam_re.astype(f32), lam_im.astype(f32))
    dt = jnp.exp(log_dt.astype(f32))[:, None]
    lam_bar = jnp.exp(lam * dt)
    b = lax.complex(b_re.astype(f32), b_im.astype(f32))
    b_bar = ((lam_bar - 1.0) / lam)[..., None] * b
    bu = jnp.einsum('blgc,gpc->blgp', uf.astype(jnp.complex64), b_bar)
    a = jnp.broadcast_to(lam_bar, bu.shape)

    def combine(e1, e2):
        a1, s1 = e1
        a2, s2 = e2
        return a1 * a2, a2 * s1 + s2

    _, h = lax.associative_scan(combine, (a, bu), axis=1)
    c = lax.complex(c_re.astype(f32), c_im.astype(f32))
    y = jnp.real(jnp.einsum('blgp,gcp->blgc', h, c))
    y = y + d_skip.astype(f32).reshape(N_SSM_GROUPS, SSM_GROUP) * uf
    y = y.reshape(bsz, L, D_SSM)
    g = jax.nn.gelu(y)
    out = g * jax.nn.sigmoid(g @ w_glu.astype(f32) + b_glu.astype(f32))
    return out.astype(u.dtype)


def mla_mixer(q_a, kv_a, k_pe, q_a_norm, w_q_b, kv_a_norm, w_kv_b, cos, sin, chunk_id):
    bsz, L, _ = q_a.shape
    q = (rmsnorm(q_a, q_a_norm) @ w_q_b).reshape(bsz, L, MLA_HEADS, QK_NOPE + QK_ROPE)
    q_nope, q_pe = q[..., :QK_NOPE], q[..., QK_NOPE:]
    q_pe = rotary(q_pe, cos[:, None, :], sin[:, None, :])
    kv = (rmsnorm(kv_a, kv_a_norm) @ w_kv_b).reshape(bsz, L, MLA_HEADS, QK_NOPE + V_HEAD)
    k_nope, v = kv[..., :QK_NOPE], kv[..., QK_NOPE:]
    k_pe = rotary(k_pe, cos, sin)
    scale = 1.0 / math.sqrt(QK_NOPE + QK_ROPE)

    n_blk = -(-L // Q_BLOCK)
    pad = n_blk * Q_BLOCK - L

    def to_blocks(t):
        t = jnp.pad(t, ((0, 0), (0, pad)) + ((0, 0),) * (t.ndim - 2))
        return jnp.moveaxis(t.reshape(bsz, n_blk, Q_BLOCK, *t.shape[2:]), 1, 0)

    q_cid = jnp.pad(chunk_id, (0, pad), constant_values=2 ** 30).reshape(n_blk, Q_BLOCK)

    def attend(args):
        qn, qp, qc = args
        s = jnp.einsum('bqhd,bkhd->bhqk', qn, k_nope, preferred_element_type=jnp.float32)
        s = s + jnp.einsum('bqhr,bkr->bhqk', qp, k_pe, preferred_element_type=jnp.float32)
        mask = chunk_id[None, :] <= qc[:, None]
        s = jnp.where(mask[None, None], s * scale, jnp.finfo(jnp.float32).min)
        p = jax.nn.softmax(s, axis=-1).astype(v.dtype)
        return jnp.einsum('bhqk,bkhd->bqhd', p, v)

    o = lax.map(attend, (to_blocks(q_nope), to_blocks(q_pe), q_cid))
    o = jnp.moveaxis(o, 0, 1).reshape(bsz, n_blk * Q_BLOCK, D_ATTN)[:, :L]
    return o


def conv_ffn(x, w_up, conv_w, conv_b, w_down):
    L = x.shape[1]
    gate, val = jnp.split(x @ w_up, 2, axis=-1)
    gp = jnp.pad(gate, ((0, 0), (CONV_W - 1, 0), (0, 0)))
    gate = sum(conv_w[k] * gp[:, k:k + L] for k in range(CONV_W)) + conv_b
    return (jax.nn.silu(gate) * val) @ w_down


def setup_inputs(seed: int = 0) -> dict:
    key = jax.random.key(seed)
    ks = jax.random.split(key, 32)
    f32 = jnp.float32
    nrm = lambda k, shape, s: jax.random.normal(k, shape, f32) * s
    gain = lambda k, shape: 1.0 + 0.01 * jax.random.normal(k, shape, f32)
    G, P, C = N_SSM_GROUPS, SSM_STATE, SSM_GROUP
    lam_re = -0.5 + 0.01 * jax.random.normal(ks[4], (DEPTH, G, P), f32)
    lam_im = jnp.pi * jnp.arange(P, dtype=f32)[None, None, :] + 0.01 * jax.random.normal(ks[5], (DEPTH, G, P), f32)
    log_dt = jax.random.uniform(ks[6], (DEPTH, G), f32, math.log(DT_MIN), math.log(DT_MAX))
    return {
        "x": jax.random.normal(ks[0], (BATCH, SEQ, D_MODEL), f32),
        "meta_tokens": nrm(ks[1], (N_META, D_MODEL), 1.0),
        "mix_norm": gain(ks[2], (DEPTH, D_MODEL)),
        "w_in": nrm(ks[3], (DEPTH, D_MODEL, D_IN), D_MODEL ** -0.5),
        "lam_re": lam_re,
        "lam_im": lam_im,
        "log_dt": log_dt,
        "b_re": nrm(ks[7], (DEPTH, G, P, C), (2 * C) ** -0.5),
        "b_im": nrm(ks[8], (DEPTH, G, P, C), (2 * C) ** -0.5),
        "c_re": nrm(ks[9], (DEPTH, G, C, P), (2 * P) ** -0.5),
        "c_im": nrm(ks[10], (DEPTH, G, C, P), (2 * P) ** -0.5),
        "d_skip": nrm(ks[11], (DEPTH, D_SSM), 1.0),
        "w_glu": nrm(ks[12], (DEPTH, D_SSM, D_SSM), D_SSM ** -0.5),
        "b_glu": nrm(ks[13], (DEPTH, D_SSM), 0.01),
        "q_a_norm": gain(ks[14], (DEPTH, Q_LORA)),
        "w_q_b": nrm(ks[15], (DEPTH, Q_LORA, MLA_HEADS * (QK_NOPE + QK_ROPE)), Q_LORA ** -0.5),
        "kv_a_norm": gain(ks[16], (DEPTH, KV_LORA)),
        "w_kv_b": nrm(ks[17], (DEPTH, KV_LORA, MLA_HEADS * (QK_NOPE + V_HEAD)), KV_LORA ** -0.5),
        "out_norm_ssm": gain(ks[18], (DEPTH, D_SSM)),
        "out_norm_attn": gain(ks[19], (DEPTH, D_ATTN)),
        "w_out": nrm(ks[20], (DEPTH, D_MIX, D_MODEL), D_MIX ** -0.5),
        "ffn_norm": gain(ks[21], (DEPTH, D_MODEL)),
        "w_up": nrm(ks[22], (DEPTH, D_MODEL, 2 * D_FF), D_MODEL ** -0.5),
        "conv_w": nrm(ks[23], (DEPTH, CONV_W, D_FF), CONV_W ** -0.5),
        "conv_b": nrm(ks[24], (DEPTH, D_FF), 0.01),
        "w_down": nrm(ks[25], (DEPTH, D_FF, D_MODEL), D_FF ** -0.5),
        "final_norm": gain(ks[26], (D_MODEL,)),
    }


def reference(x, meta_tokens, mix_norm, w_in, lam_re, lam_im, log_dt, b_re, b_im, c_re, c_im,
              d_skip, w_glu, b_glu, q_a_norm, w_q_b, kv_a_norm, w_kv_b, out_norm_ssm,
              out_norm_attn, w_out, ffn_norm, w_up, conv_w, conv_b, w_down, final_norm):
    bsz = x.shape[0]
    meta = jnp.broadcast_to(meta_tokens.astype(x.dtype)[None], (bsz, N_META, D_MODEL))
    h = jnp.concatenate([meta, x], axis=1)
    L = h.shape[1]

    pos = jnp.arange(L, dtype=jnp.int32)
    chunk_id = jnp.where(pos < N_META, 0, 1 + (pos - N_META) // CHUNK)
    inv_freq = 1.0 / (ROPE_BASE ** (jnp.arange(0, QK_ROPE, 2, dtype=jnp.float32) / QK_ROPE))
    ang = pos.astype(jnp.float32)[:, None] * inv_freq[None, :]
    cos = jnp.cos(ang).astype(x.dtype)
    sin = jnp.sin(ang).astype(x.dtype)

    for i in range(DEPTH):
        xn = rmsnorm(h, mix_norm[i])
        z = xn @ w_in[i]
        o1 = D_SSM
        o2 = o1 + Q_LORA
        o3 = o2 + KV_LORA
        u, q_a, kv_a, k_pe = z[..., :o1], z[..., o1:o2], z[..., o2:o3], z[..., o3:]
        ya = s5_mixer(u, lam_re[i], lam_im[i], log_dt[i], b_re[i], b_im[i], c_re[i], c_im[i],
                      d_skip[i], w_glu[i], b_glu[i])
        yb = mla_mixer(q_a, kv_a, k_pe, q_a_norm[i], w_q_b[i], kv_a_norm[i], w_kv_b[i],
                       cos, sin, chunk_id)
        y = jnp.concatenate([rmsnorm(ya, out_norm_ssm[i]), rmsnorm(yb, out_norm_attn[i])], axis=-1)
        h = h + y @ w_out[i]
        h = h + conv_ffn(rmsnorm(h, ffn_norm[i]), w_up[i], conv_w[i], conv_b[i], w_down[i])

    return rmsnorm(h, final_norm)[:, N_META:]
```

```cpp
#include <hip/hip_runtime.h>
#include <hip/hip_cooperative_groups.h>
#include <cstdio>
#include <cstdint>
namespace cg = cooperative_groups;

#define LAS __attribute__((address_space(3)))
typedef unsigned short bf16_t;
typedef short bf16x8 __attribute__((ext_vector_type(8)));
typedef float f32x4 __attribute__((ext_vector_type(4)));
typedef float f32x16 __attribute__((ext_vector_type(16)));
typedef unsigned u32x4 __attribute__((ext_vector_type(4)));
typedef unsigned u32x2 __attribute__((ext_vector_type(2)));

constexpr int NB = 8, NMETA = 16, LL = 2064, DM = 2048, ROWS = NB * LL, MPAD = 16640;
constexpr int NG = 64, DFF = 5504;
constexpr int NCH = 129, GRP = 1280, XSK = 384, XHB = 2050;
constexpr float EPS = 1e-6f;
constexpr float QSCALE = 0.07216878364870322f * 1.4426950408889634f;
constexpr int NTHR = 512;

constexpr size_t al(size_t x) { return (x + 255) & ~(size_t)255; }
constexpr size_t O_WIN = 0;
constexpr size_t O_WGLU = O_WIN + al((size_t)2048 * 2048 * 2);
constexpr size_t O_WQ = O_WGLU + al((size_t)1024 * 1024 * 2);
constexpr size_t O_WKV = O_WQ + al((size_t)1536 * 512 * 2);
constexpr size_t O_WOUT = O_WKV + al((size_t)2048 * 256 * 2);
constexpr size_t O_WUP = O_WOUT + al((size_t)2048 * 2048 * 2);
constexpr size_t O_WD = O_WUP + al((size_t)11008 * 2048 * 2);
constexpr size_t O_MST = O_WD + al((size_t)2048 * 5504 * 2);
constexpr size_t O_MIO = O_MST + al((size_t)64 * 256 * 256 * 2);
constexpr size_t O_KD = O_MIO + al((size_t)64 * 256 * 384 * 2);
constexpr size_t O_PWC = O_KD + al((size_t)64 * 16 * 256 * 4);
constexpr size_t O_PW1 = O_PWC + al((size_t)4096 * 16 * 8);
constexpr size_t O_COS = O_PW1 + al((size_t)4096 * 16 * 8);
constexpr size_t O_SIN = O_COS + al((size_t)LL * 32 * 4);
constexpr size_t O_SSQ = O_SIN + al((size_t)LL * 32 * 4);
constexpr size_t O_BAR = O_SSQ + al((size_t)7 * MPAD * 4);
constexpr size_t O_Y = O_BAR + al((size_t)4096 * 4);
constexpr size_t O_E = O_Y + al((size_t)MPAD * 2048 * 2);
constexpr size_t O_XN = O_E;
constexpr size_t O_XS = O_XN + al((size_t)MPAD * 2048 * 2);
constexpr size_t O_QA = O_XS + al((size_t)64 * GRP * XSK * 2);
constexpr size_t O_KVA = O_QA + al((size_t)MPAD * 512 * 2);
constexpr size_t O_KPE = O_KVA + al((size_t)MPAD * 256 * 2);
constexpr size_t O_Q = O_KPE + al((size_t)MPAD * 64 * 2);
constexpr size_t O_KN = O_Q + al((size_t)MPAD * 1536 * 2);
constexpr size_t O_VT = O_KN + al((size_t)MPAD * 1024 * 2);
constexpr size_t O_S = O_VT + al((size_t)(NB + 1) * 8 * 128 * 2048 * 2 + 4096);
constexpr size_t O_END1 = O_S + al((size_t)64 * GRP * 128 * 4);
constexpr size_t O_G = O_Q;
constexpr size_t O_ACT = O_E + al((size_t)(NB * XHB + 16) * 2048 * 2);
constexpr size_t O_XH = O_ACT + al((size_t)16384 * DFF * 2);
constexpr size_t O_END2 = O_XH + al((size_t)(NB * XHB + 16) * 2048 * 2);
static_assert(O_XH >= O_KN, "XH must not overlap G (= Q region), read in P5");
static_assert(O_END1 <= (size_t)536870912 && O_END2 <= (size_t)536870912, "workspace map exceeds 512 MiB");

#ifndef PH_MASK
#define PH_MASK 0x3ff
#endif
#define PH_ON(n) ((PH_MASK >> (n)) & 1)
#ifndef DUP_MASK
#define DUP_MASK 0
#endif
#define DUP_ON(n) ((DUP_MASK >> (n)) & 1)
struct Params { const float* in[27]; float* out; unsigned char* ws; };

__device__ __forceinline__ unsigned cvt_pk(float lo, float hi) { unsigned r; asm volatile("v_cvt_pk_bf16_f32 %0, %1, %2" : "=v"(r) : "v"(lo), "v"(hi)); return r; }
__device__ __forceinline__ u32x2 pack4(f32x4 v) { u32x2 r; r.x = cvt_pk(v[0], v[1]); r.y = cvt_pk(v[2], v[3]); return r; }
__device__ __forceinline__ float bf2f(unsigned short b) { return __builtin_bit_cast(float, (unsigned)b << 16); }
__device__ __forceinline__ f32x4 unpack4(u32x2 w) { f32x4 r; r[0] = __builtin_bit_cast(float, w.x << 16); r[1] = __builtin_bit_cast(float, w.x & 0xffff0000u); r[2] = __builtin_bit_cast(float, w.y << 16); r[3] = __builtin_bit_cast(float, w.y & 0xffff0000u); return r; }
__device__ __forceinline__ float wave_sum(float v) {
#pragma unroll
    for (int o = 1; o < 64; o <<= 1) v += __shfl_xor(v, o);
    return v;
}
__device__ __forceinline__ float dpp_shr1(float v) { return __builtin_bit_cast(float, __builtin_amdgcn_update_dpp(0, __builtin_bit_cast(int, v), 0x111, 0xf, 0xf, true)); }
__device__ __forceinline__ float dpp_shr2(float v) { return __builtin_bit_cast(float, __builtin_amdgcn_update_dpp(0, __builtin_bit_cast(int, v), 0x112, 0xf, 0xf, true)); }
__device__ __forceinline__ float dot4(u32x2 a, u32x2 k) {
    return __builtin_bit_cast(float, a.x << 16) * __builtin_bit_cast(float, k.x << 16) + __builtin_bit_cast(float, a.x & 0xffff0000u) * __builtin_bit_cast(float, k.x & 0xffff0000u)
         + __builtin_bit_cast(float, a.y << 16) * __builtin_bit_cast(float, k.y << 16) + __builtin_bit_cast(float, a.y & 0xffff0000u) * __builtin_bit_cast(float, k.y & 0xffff0000u);
}
__device__ __forceinline__ bf16_t f2bf(float v) { return (bf16_t)(cvt_pk(v, 0.f) & 0xffff); }
__device__ __forceinline__ float fexp2(float x) { return __builtin_amdgcn_exp2f(x); }
__device__ __forceinline__ float sigmoidf_(float x) { return __builtin_amdgcn_rcpf(1.0f + __builtin_amdgcn_exp2f(-1.4426950408889634f * x)); }

constexpr int BM = 256, BK = 64, HALF = 128, HTB = HALF * BK * 2, STAGE_BYTES = 8 * HTB;
constexpr int EPF_OFF = STAGE_BYTES + 16384 + 64, EPF_WAVE = 1536;
constexpr int LDS_BYTES = EPF_OFF + 8 * EPF_WAVE;
static_assert(LDS_BYTES <= 163840, "LDS");

__device__ __forceinline__ int lds_byte(int r, int c) { const int st = (r >> 4) * 2 + (c >> 5), rr = r & 15, cc = c & 31, ob = rr * 64 + cc * 2; return st * 1024 + (ob ^ (((ob >> 9) & 1) << 5)); }
__device__ __forceinline__ void stage_rc(int b, int& R, int& C) { const int st = b / 1024, sb = b % 1024, swz = sb ^ (((sb >> 9) & 1) << 5); R = (st >> 1) * 16 + swz / 64; C = (st & 1) * 32 + (swz % 64) / 2; }

struct Unit { int pm, pn, bt; };

template <int MODE>
struct GSched {
    const char* A; const char* Bt; int lda, K; size_t strideA, strideB; int nM, nN, nB, G, c; long nwg;
    __device__ __forceinline__ void init(const void* A_, const void* Bt_, int lda_, int K_, int nM_, int nN_, int nB_, size_t sA, size_t sB) {
        A = (const char*)A_; Bt = (const char*)Bt_; lda = lda_; K = K_; nM = nM_; nN = nN_; nB = nB_; strideA = sA; strideB = sB; G = gridDim.x; c = blockIdx.x; nwg = (long)nM * nN * nB;
    }
    __device__ __forceinline__ bool next(int i, Unit& u) const {
        if (MODE == 2) { if (i >= 2) return false; const int x = c & 7, y = c >> 3; u.pm = 32 * i + 4 * x + (y >> 3); u.pn = y & 7; u.bt = 0; return true; }
        const long L = (long)i * G + c; if (L >= nwg) return false;
        const int per = nM * nN; const int bt = (int)(L / per); int w = (int)(L - (long)bt * per);
        if (nB == 1) { const int q = per / 8, r = per % 8, xcd = w % 8, off = w / 8; w = (xcd < r ? xcd * (q + 1) : r * (q + 1) + (xcd - r) * q) + off; }
        const int nig = 8 * nN, gid = w / nig, fm = gid * 8, gsz = (nM - fm) < 8 ? (nM - fm) : 8;
        u.pm = fm + ((w % nig) % gsz); u.pn = (w % nig) / gsz; u.bt = bt; return true;
    }
    __device__ __forceinline__ const char* a_base(const Unit& u) const {
        if (MODE == 1) { if (u.pm == 64) return A; return A + (size_t)((u.pm >> 3) * XHB + (u.pm & 7) * 256) * lda * 2; }
        return A + (size_t)u.bt * strideA + (size_t)u.pm * 256 * lda * 2;
    }
    __device__ __forceinline__ size_t a_hstep(const Unit& u) const { if (MODE == 1 && u.pm == 64) return (size_t)4 * XHB * lda * 2; return (size_t)HALF * lda * 2; }
    __device__ __forceinline__ unsigned a_voff(const Unit& u, int R, int C) const {
        if (MODE == 1 && u.pm == 64) return (unsigned)(((R >> 5) * XHB + ((R >> 2) & 7) * 256 + 254 + (R & 3)) * lda + C) * 2u;
        return (unsigned)(R * lda + C) * 2u;
    }
    __device__ __forceinline__ const char* b_base(const Unit& u) const { return Bt + (size_t)u.bt * strideB + (size_t)u.pn * 256 * K * 2; }
};

template <class Epi, class Sched>
__device__ __forceinline__ void gemm_phase(LAS unsigned char* lds, const Sched& S, const Epi& E) {
    int tid = threadIdx.x; asm volatile("" : "+v"(tid));
    const int wid = __builtin_amdgcn_readfirstlane(tid >> 6), lane = tid & 63, wr = wid >> 2, wc = wid & 3, fr = lane & 15, fq = lane >> 4;
    const int K = S.K, nt = K / BK;
    int sR[2], sC[2]; unsigned voffB[2];
#pragma unroll
    for (int i = 0; i < 2; ++i) { stage_rc(tid * 16 + i * 8192, sR[i], sC[i]); voffB[i] = (unsigned)(sR[i] * K + sC[i]) * 2u; }
    const size_t kstep = (size_t)(BK * 2), hstepB = (size_t)HALF * K * 2;
    const unsigned ldsw = (unsigned)wid * 1024u;
    const int aoff = lds_byte(wr * 64 + fr, fq * 8), boff = lds_byte(wc * 32 + fr, fq * 8);
#define G_SA(b, h) (((b) * 2 + (h)) * HTB)
#define G_SB(b, h) ((4 + (b) * 2 + (h)) * HTB)
#define G_STAGE(bufoff, gbase, v0, v1) do { \
        __builtin_amdgcn_global_load_lds((const unsigned*)((const char*)(gbase) + (v0)), (LAS unsigned*)(lds + (bufoff) + ldsw), 16, 0, 0); \
        __builtin_amdgcn_global_load_lds((const unsigned*)((const char*)(gbase) + (v1)), (LAS unsigned*)(lds + (bufoff) + ldsw + 8192), 16, 0, 0); } while (0)
#define G_LDA(dst, b, h) do { _Pragma("unroll") for (int m = 0; m < 4; ++m) _Pragma("unroll") for (int k = 0; k < 2; ++k) dst[m][k] = *(const LAS bf16x8*)(lds + G_SA(b, h) + aoff + m * 2048 + k * 1024); } while (0)
#define G_LDB(dst, b, h) do { _Pragma("unroll") for (int n = 0; n < 2; ++n) _Pragma("unroll") for (int k = 0; k < 2; ++k) dst[n][k] = *(const LAS bf16x8*)(lds + G_SB(b, h) + boff + n * 2048 + k * 1024); } while (0)
#define G_MMA(ai, bj, At, Bt) do { __builtin_amdgcn_s_setprio(1); _Pragma("unroll") for (int m = 0; m < 4; ++m) _Pragma("unroll") for (int n = 0; n < 2; ++n) _Pragma("unroll") for (int k = 0; k < 2; ++k) \
        acc[ai][bj][m][n] = __builtin_amdgcn_mfma_f32_16x16x32_bf16(Bt[n][k], At[m][k], acc[ai][bj][m][n], 0, 0, 0); __builtin_amdgcn_s_setprio(0); } while (0)
#define G_WAIT_V(n) asm volatile("s_waitcnt vmcnt(" #n ")" ::: "memory")
#define G_WAIT_L(n) asm volatile("s_waitcnt lgkmcnt(" #n ")" ::: "memory")
#define G_BAR __builtin_amdgcn_s_barrier()
#define G_SCHED __builtin_amdgcn_sched_barrier(0)
    Unit cur, nxt; int ui = 0;
    if (!S.next(0, cur)) return;
    f32x4 acc[2][2][4][2];
#pragma unroll
    for (int a = 0; a < 2; ++a)
#pragma unroll
        for (int b = 0; b < 2; ++b)
#pragma unroll
            for (int m = 0; m < 4; ++m)
#pragma unroll
                for (int n = 0; n < 2; ++n) acc[a][b][m][n] = (f32x4){0.f, 0.f, 0.f, 0.f};
    bf16x8 At[4][2], B0[2][2], B1[2][2];
    const char* cA = S.a_base(cur); const char* cB = S.b_base(cur);
    unsigned vc0 = S.a_voff(cur, sR[0], sC[0]), vc1 = S.a_voff(cur, sR[1], sC[1]); size_t hAc = S.a_hstep(cur);
    const unsigned vb0 = voffB[0], vb1 = voffB[1];
    if constexpr (Epi::PREFETCH) E.prefetch(cur, wr, wc, lane, lds + EPF_OFF + wid * EPF_WAVE);
    G_STAGE(G_SB(0, 0), cB, vb0, vb1); G_STAGE(G_SB(0, 1), cB + hstepB, vb0, vb1); G_STAGE(G_SA(0, 0), cA, vc0, vc1); G_STAGE(G_SA(0, 1), cA + hAc, vc0, vc1);
    if (wr == 1) G_BAR;
    G_WAIT_V(2); G_BAR;
    G_STAGE(G_SB(1, 0), cB + kstep, vb0, vb1); G_STAGE(G_SA(1, 0), cA + kstep, vc0, vc1); G_STAGE(G_SB(1, 1), cB + hstepB + kstep, vb0, vb1);
    G_WAIT_V(6); G_BAR;
    for (;;) {
        const bool has_next = S.next(ui + 1, nxt);
        const char* nA = has_next ? S.a_base(nxt) : cA; const char* nB = has_next ? S.b_base(nxt) : cB;
        const unsigned vn0 = has_next ? S.a_voff(nxt, sR[0], sC[0]) : vc0, vn1 = has_next ? S.a_voff(nxt, sR[1], sC[1]) : vc1; const size_t hAn = has_next ? S.a_hstep(nxt) : hAc;
        for (int t = 0; t < nt; t += 2) {
            const bool last = (t == nt - 2);
            if constexpr (Epi::MIDSCALE) { if (t == nt / 2) { int e_fr = fr, e_wr = wr; asm volatile("" : "+v"(e_fr)); asm volatile("" : "+s"(e_wr)); E.mid(acc, cur, e_wr, e_fr); } }
            const char* a1 = cA + (size_t)(t + 1) * kstep;
            const char* a2 = last ? nA : cA + (size_t)(t + 2) * kstep; const char* b2 = last ? nB : cB + (size_t)(t + 2) * kstep;
            const char* a3 = a2 + kstep; const char* b3 = b2 + kstep;
            const unsigned v20 = last ? vn0 : vc0, v21 = last ? vn1 : vc1; const size_t h2 = last ? hAn : hAc;
            G_LDB(B0, 0, 0); G_LDB(B1, 0, 1); G_SCHED; G_LDA(At, 0, 0); G_STAGE(G_SA(1, 1), a1 + hAc, vc0, vc1);
            G_WAIT_V(8); G_WAIT_L(0); G_BAR; G_MMA(0, 0, At, B0); G_MMA(0, 1, At, B1); G_BAR; G_SCHED;
            G_LDA(At, 0, 1); G_STAGE(G_SB(0, 0), b2, vb0, vb1); G_STAGE(G_SB(0, 1), b2 + hstepB, vb0, vb1); G_STAGE(G_SA(0, 0), a2, v20, v21);
            G_WAIT_V(8); G_WAIT_L(0); G_BAR; G_MMA(1, 0, At, B0); G_MMA(1, 1, At, B1); G_BAR; G_SCHED;
            G_LDB(B0, 1, 0); G_LDB(B1, 1, 1); G_SCHED; G_LDA(At, 1, 0); G_STAGE(G_SA(0, 1), a2 + h2, v20, v21);
            G_WAIT_V(8); G_WAIT_L(0); G_BAR; G_MMA(0, 0, At, B0); G_MMA(0, 1, At, B1); G_BAR; G_SCHED;
            G_LDA(At, 1, 1); G_STAGE(G_SB(1, 0), b3, vb0, vb1); G_STAGE(G_SB(1, 1), b3 + hstepB, vb0, vb1); G_STAGE(G_SA(1, 0), a3, v20, v21);
            G_WAIT_V(8); G_WAIT_L(0); G_BAR; G_MMA(1, 0, At, B0); G_MMA(1, 1, At, B1); G_BAR; G_SCHED;
        }
        if (wr == 0) G_BAR;
        { int e_fr = fr, e_fq = fq, e_wr = wr, e_wc = wc; asm volatile("" : "+v"(e_fr), "+v"(e_fq)); asm volatile("" : "+s"(e_wr), "+s"(e_wc));
          E(acc, cur, e_wr, e_wc, e_fr, e_fq, lds + STAGE_BYTES);
          if constexpr (Epi::PREFETCH) { if (has_next) { int e_lane = lane; asm volatile("" : "+v"(e_lane)); E.prefetch(nxt, e_wr, e_wc, e_lane, lds + EPF_OFF + wid * EPF_WAVE); } } }
        if (!has_next) break;
#pragma unroll
        for (int a = 0; a < 2; ++a)
#pragma unroll
            for (int b = 0; b < 2; ++b)
#pragma unroll
                for (int m = 0; m < 4; ++m)
#pragma unroll
                    for (int n = 0; n < 2; ++n) acc[a][b][m][n] = (f32x4){0.f, 0.f, 0.f, 0.f};
        cur = nxt; cA = nA; cB = nB; vc0 = vn0; vc1 = vn1; hAc = hAn; ++ui;
        if (wr == 1) G_BAR;
    }
    G_WAIT_V(0);
    G_BAR;
}

#define EPI_ARGS f32x4 (&acc)[2][2][4][2], const Unit& u, int wr, int wc, int fr, int fq, LAS unsigned char* xl
#define FOR_AI_M _Pragma("unroll") for (int ai = 0; ai < 2; ++ai) _Pragma("unroll") for (int m = 0; m < 4; ++m)
#define FOR_BJ_N _Pragma("unroll") for (int bj = 0; bj < 2; ++bj) _Pragma("unroll") for (int n = 0; n < 2; ++n)

struct EpiZ {
    static constexpr bool MIDSCALE = false, PREFETCH = false;
    bf16_t* XS; bf16_t* QA; bf16_t* KVA; bf16_t* KPE; float* ssq_q; float* ssq_kv; const float* cs; const float* sn;
    __device__ __forceinline__ void operator()(EPI_ARGS) const {
        const int pn = u.pn;
        FOR_AI_M {
            const int row = u.pm * 256 + ai * 128 + wr * 64 + m * 16 + fr;
            if (pn < 4) {
                FOR_BJ_N { const int g = 16 * pn + 8 * bj + 2 * wc + n;
                    *(u32x2*)(XS + ((size_t)(g * GRP + (row >> 4)) * XSK + (row & 15) * 16 + 4 * fq)) = pack4(acc[ai][bj][m][n]); }
            } else if (pn < 7) {
                float ss = 0.f;
                FOR_BJ_N { const f32x4 v = acc[ai][bj][m][n]; ss += v[0] * v[0] + v[1] * v[1] + v[2] * v[2] + v[3] * v[3];
                    const int col = bj * 128 + wc * 32 + n * 16 + 4 * fq;
                    if (pn < 6) *(u32x2*)(QA + ((size_t)row * 512 + (pn - 4) * 256 + col)) = pack4(v);
                    else *(u32x2*)(KVA + ((size_t)row * 256 + col)) = pack4(v); }
                ss += __shfl_xor(ss, 16); ss += __shfl_xor(ss, 32);
                if (fq == 0 && ssq_q) atomicAdd((pn < 6 ? ssq_q : ssq_kv) + row, ss);
            } else {
                if (wc < 2) {
                    const int t = (row & 2047) + 16; const f32x4 x1 = acc[ai][0][m][0], x2 = acc[ai][0][m][1]; f32x4 y1, y2;
                    const f32x4 c = *(const f32x4*)(cs + t * 32 + wc * 16 + 4 * fq), s = *(const f32x4*)(sn + t * 32 + wc * 16 + 4 * fq);
#pragma unroll
                    for (int e = 0; e < 4; ++e) { y1[e] = x1[e] * c[e] - x2[e] * s[e]; y2[e] = x2[e] * c[e] + x1[e] * s[e]; }
                    *(u32x2*)(KPE + ((size_t)row * 64 + wc * 32 + 4 * fq)) = pack4(y1);
                    *(u32x2*)(KPE + ((size_t)row * 64 + wc * 32 + 16 + 4 * fq)) = pack4(y2);
                }
            }
        }
    }
};

struct EpiQ {
    static constexpr bool MIDSCALE = false, PREFETCH = false;
    bf16_t* Q; const float* ssq_q; const float* cs; const float* sn;
    __device__ __forceinline__ void operator()(EPI_ARGS) const {
        FOR_AI_M {
            const int row = u.pm * 256 + ai * 128 + wr * 64 + m * 16 + fr;
            const float rs = rsqrtf(ssq_q[row] * (1.0f / 512.0f) + EPS) * QSCALE;
            const int t = (row & 2047) + 16;
#pragma unroll
            for (int bj = 0; bj < 2; ++bj) {
                const int cb = u.pn * 256 + bj * 128 + wc * 32;
                f32x4 v0 = acc[ai][bj][m][0] * rs, v1 = acc[ai][bj][m][1] * rs;
                if (((cb >> 6) % 3) == 2) {
                    const int j = (wc & 1) * 16 + 4 * fq;
                    const f32x4 c = *(const f32x4*)(cs + t * 32 + j), s = *(const f32x4*)(sn + t * 32 + j); f32x4 y1, y2;
#pragma unroll
                    for (int e = 0; e < 4; ++e) { y1[e] = v0[e] * c[e] - v1[e] * s[e]; y2[e] = v1[e] * c[e] + v0[e] * s[e]; }
                    v0 = y1; v1 = y2;
                }
                *(u32x2*)(Q + ((size_t)row * 1536 + cb + 4 * fq)) = pack4(v0);
                *(u32x2*)(Q + ((size_t)row * 1536 + cb + 16 + 4 * fq)) = pack4(v1);
            }
        }
    }
};

struct EpiKV {
    static constexpr bool MIDSCALE = false, PREFETCH = false;
    bf16_t* KN; bf16_t* VT; const float* ssq_kv;
    __device__ __forceinline__ void operator()(EPI_ARGS) const {
        FOR_AI_M {
            const int row = u.pm * 256 + ai * 128 + wr * 64 + m * 16 + fr;
            {
                const float rs = rsqrtf(ssq_kv[row] * (1.0f / 256.0f) + EPS);
                const int b = row >> 11, t = row & 2047;
#pragma unroll
                for (int n = 0; n < 2; ++n) {
                    *(u32x2*)(KN + ((size_t)row * 1024 + u.pn * 128 + wc * 32 + n * 16 + 4 * fq)) = pack4(acc[ai][0][m][n] * rs);
                    const f32x4 v = acc[ai][1][m][n] * rs; const int d = wc * 32 + n * 16 + 4 * fq;
                    bf16_t* vp = VT + ((size_t)((b * 8 + u.pn) * 128 + d)) * 2048 + t;
                    const unsigned w0 = cvt_pk(v[0], v[1]), w1 = cvt_pk(v[2], v[3]);
                    vp[0] = (bf16_t)(w0 & 0xffff); vp[2048] = (bf16_t)(w0 >> 16); vp[2 * 2048] = (bf16_t)(w1 & 0xffff); vp[3 * 2048] = (bf16_t)(w1 >> 16);
                }
            }
        }
    }
};

struct EpiS {
    static constexpr bool MIDSCALE = false, PREFETCH = false;
    float* S;
    __device__ __forceinline__ void operator()(EPI_ARGS) const {
        FOR_AI_M {
            const int R = u.pm * 256 + ai * 128 + wr * 64 + m * 16 + fr;
#pragma unroll
            for (int n = 0; n < 2; ++n) *(f32x4*)(S + ((size_t)(u.bt * GRP + R) * 128 + wc * 32 + n * 16 + 4 * fq)) = acc[ai][0][m][n];
        }
    }
};

struct EpiY {
    static constexpr bool MIDSCALE = false, PREFETCH = false;
    const bf16_t* XS; bf16_t* G; const float* dskip;
    __device__ __forceinline__ void operator()(EPI_ARGS) const {
        const int g = u.bt;
        const f32x4 dk = *(const f32x4*)(dskip + g * 16 + 4 * fq);
        FOR_AI_M {
            const int R = u.pm * 256 + ai * 128 + wr * 64 + m * 16 + fr;
            {
                FOR_BJ_N { const int col = bj * 128 + wc * 32 + n * 16 + 4 * fq; const int t = col >> 4;
                    const int grow = R * 16 + t;
                    const f32x4 uu = unpack4(*(const u32x2*)(XS + ((size_t)(g * GRP + R) * XSK + col)));
                    f32x4 y = acc[ai][bj][m][n] + dk * uu, o;
#pragma unroll
                    for (int e = 0; e < 4; ++e) { const float a = y[e]; o[e] = a * sigmoidf_(1.5957691216f * (a + 0.044715f * a * a * a)); }
                    *(u32x2*)(G + ((size_t)grow * 1024 + g * 16 + 4 * fq)) = pack4(o); }
            }
        }
    }
};

struct EpiGlu {
    static constexpr bool MIDSCALE = false, PREFETCH = false;
    const bf16_t* G; bf16_t* Y; const float* bglu; float* ssq_a;
    __device__ __forceinline__ void operator()(EPI_ARGS) const {
        FOR_AI_M {
            const int row = u.pm * 256 + ai * 128 + wr * 64 + m * 16 + fr; float ss = 0.f;
            FOR_BJ_N { const int col = u.pn * 256 + bj * 128 + wc * 32 + n * 16 + 4 * fq;
                const f32x4 gg = unpack4(*(const u32x2*)(G + ((size_t)row * 1024 + col))); const f32x4 bb = *(const f32x4*)(bglu + col); f32x4 o;
#pragma unroll
                for (int e = 0; e < 4; ++e) { o[e] = gg[e] * sigmoidf_(acc[ai][bj][m][n][e] + bb[e]); ss += o[e] * o[e]; }
                *(u32x2*)(Y + ((size_t)row * 2048 + col)) = pack4(o); }
            ss += __shfl_xor(ss, 16); ss += __shfl_xor(ss, 32);
            if (fq == 0) atomicAdd(ssq_a + row, ss);
        }
    }
};

struct EpiOut {
    static constexpr bool MIDSCALE = true, PREFETCH = false;
    const float* ssq_a; const float* ssq_b; const bf16_t* XN; const float* rinvx; const float* gmix; bf16_t* XH; float* ssq_h;
    __device__ __forceinline__ void mid(f32x4 (&acc)[2][2][4][2], const Unit& u, int wr, int fr) const {
        FOR_AI_M {
            const int row = u.pm * 256 + ai * 128 + wr * 64 + m * 16 + fr;
            const float ra = rsqrtf(ssq_a[row] * (1.0f / 1024.0f) + EPS), rb = rsqrtf(ssq_b[row] * (1.0f / 1024.0f) + EPS); const float r = ra / rb;
            FOR_BJ_N acc[ai][bj][m][n] *= r;
        }
    }
    __device__ __forceinline__ void operator()(EPI_ARGS) const {
        f32x4 ginv[2][2];
        FOR_BJ_N { const f32x4 gg = *(const f32x4*)(gmix + u.pn * 256 + bj * 128 + wc * 32 + n * 16 + 4 * fq);
#pragma unroll
            for (int e = 0; e < 4; ++e) ginv[bj][n][e] = __builtin_amdgcn_rcpf(gg[e]); }
        FOR_AI_M {
            const int row = u.pm * 256 + ai * 128 + wr * 64 + m * 16 + fr;
            const float rb = rsqrtf(ssq_b[row] * (1.0f / 1024.0f) + EPS), ri = rinvx[row];
            const int b = row >> 11, tp = row & 2047;
            const bf16_t* hrow = XN + (size_t)row * 2048;
            float ss = 0.f;
            FOR_BJ_N { const int col = u.pn * 256 + bj * 128 + wc * 32 + n * 16 + 4 * fq;
                const f32x4 v = acc[ai][bj][m][n] * rb + unpack4(*(const u32x2*)(hrow + col)) * (ginv[bj][n] * ri);
                ss += v[0] * v[0] + v[1] * v[1] + v[2] * v[2] + v[3] * v[3];
                *(u32x2*)(XH + ((size_t)(b * XHB + tp + 2) * 2048 + col)) = pack4(v); }
            ss += __shfl_xor(ss, 16); ss += __shfl_xor(ss, 32);
            if (fq == 0) atomicAdd(ssq_h + b * XHB + tp + 2, ss);
        }
    }
};

struct EpiUp {
    static constexpr bool MIDSCALE = false, PREFETCH = true;
    bf16_t* ACT; const float* ssq_h; const float* cw; const float* cb;
    __device__ __forceinline__ void prefetch(const Unit& u, int wr, int wc, int lane, LAS unsigned char* pf) const {
        const bool gather = (u.pm == 64);
#pragma unroll
        for (int ai = 0; ai < 2; ++ai) {
            const int R = ai * 128 + wr * 64 + lane;
            const int xrow = gather ? ((R >> 5) * XHB + ((R >> 2) & 7) * 256 + 254 + (R & 3)) : ((u.pm >> 3) * XHB + (u.pm & 7) * 256 + R);
            __builtin_amdgcn_global_load_lds((const unsigned*)(ssq_h + xrow), (LAS unsigned*)(pf + ai * 256), 4, 0, 0);
        }
        const int l5 = lane & 31, a = l5 >> 3, piece = l5 & 7;
        const float* src = (a < 3 ? cw + a * DFF : cb) + u.pn * 128 + wc * 32 + piece * 4;
        __builtin_amdgcn_global_load_lds((const unsigned*)src, (LAS unsigned*)(pf + 512), 16, 0, 0);
    }
    __device__ __forceinline__ void operator()(EPI_ARGS) const {
        LAS float* halo = (LAS float*)xl;
        const bool gather = (u.pm == 64);
        const LAS float* pf = (const LAS float*)(xl + (EPF_OFF - STAGE_BYTES) + (wr * 4 + wc) * EPF_WAVE);
        float rsv[2][4];
        FOR_AI_M { rsv[ai][m] = pf[ai * 64 + m * 16 + fr]; }
        f32x4 W0[2], W1[2], W2[2], BB[2];
#pragma unroll
        for (int n = 0; n < 2; ++n) { const int c8 = 8 * fq + 4 * n;
            W0[n] = *(const LAS f32x4*)(pf + 128 + c8); W1[n] = *(const LAS f32x4*)(pf + 128 + 32 + c8); W2[n] = *(const LAS f32x4*)(pf + 128 + 64 + c8); BB[n] = *(const LAS f32x4*)(pf + 128 + 96 + c8); }
        FOR_AI_M {
            const float rs = rsqrtf(rsv[ai][m] * (1.0f / 2048.0f) + EPS);
            FOR_BJ_N acc[ai][bj][m][n] *= rs;
            if (fr >= 14) {
                const int rb = ai * 8 + wr * 4 + m;
#pragma unroll
                for (int n = 0; n < 2; ++n) *(LAS f32x4*)(halo + ((rb * 2 + (fr - 14)) * 128 + wc * 32 + 8 * fq + 4 * n)) = acc[ai][0][m][n];
            }
        }
        asm volatile("s_waitcnt lgkmcnt(0)" ::: "memory"); __builtin_amdgcn_s_barrier(); asm volatile("" ::: "memory");
        FOR_AI_M {
            const int R = ai * 128 + wr * 64 + m * 16 + fr; const int rb = ai * 8 + wr * 4 + m;
            u32x4 ow;
            const bool valid = gather ? ((R & 3) >= 2) : (R >= 2);
            const int orow = gather ? (256 * (R >> 2) + 252 + (R & 3)) : (256 * u.pm + R - 2);
#pragma unroll
            for (int n = 0; n < 2; ++n) {
                const int cl = wc * 32 + 8 * fq + 4 * n;
                f32x4 hA = (f32x4){0.f, 0.f, 0.f, 0.f}, hB = (f32x4){0.f, 0.f, 0.f, 0.f};
                if (fr < 2 && rb > 0) { hA = *(const LAS f32x4*)(halo + (((rb - 1) * 2 + fr) * 128 + cl)); if (fr == 0) hB = *(const LAS f32x4*)(halo + (((rb - 1) * 2 + 1) * 128 + cl)); }
                const f32x4 g0 = acc[ai][0][m][n], vv = acc[ai][1][m][n];
                f32x4 d1, d2;
#pragma unroll
                for (int e = 0; e < 4; ++e) { d1[e] = dpp_shr1(g0[e]); d2[e] = dpp_shr2(g0[e]); }
                const f32x4 g1 = d1 + hB, g2 = d2 + hA;
                const f32x4 cv = W0[n] * g2 + (W1[n] * g1 + (W2[n] * g0 + BB[n]));
                const f32x4 tt = cv * -1.4426950408889634f; f32x4 den;
#pragma unroll
                for (int e = 0; e < 4; ++e) den[e] = __builtin_amdgcn_exp2f(tt[e]);
                den = den + 1.0f; f32x4 rc;
#pragma unroll
                for (int e = 0; e < 4; ++e) rc[e] = __builtin_amdgcn_rcpf(den[e]);
                const f32x4 o = (cv * rc) * vv;
                const u32x2 pk = pack4(o); if (n == 0) { ow.x = pk.x; ow.y = pk.y; } else { ow.z = pk.x; ow.w = pk.y; }
            }
            if (valid) *(u32x4*)(ACT + ((size_t)orow * DFF + u.pn * 128 + wc * 32 + 8 * fq)) = ow;
        }
    }
};

struct EpiDown {
    static constexpr bool MIDSCALE = false, PREFETCH = false;
    const bf16_t* XH; bf16_t* H2; float* ssq_o;
    __device__ __forceinline__ void operator()(EPI_ARGS) const {
        FOR_AI_M {
            const int row = u.pm * 256 + ai * 128 + wr * 64 + m * 16 + fr; float ss = 0.f;
            const bf16_t* hrow = XH + (size_t)((row >> 11) * XHB + (row & 2047) + 2) * 2048;
            FOR_BJ_N { const int col = u.pn * 256 + bj * 128 + wc * 32 + n * 16 + 4 * fq;
                const f32x4 v = unpack4(*(const u32x2*)(hrow + col)) + acc[ai][bj][m][n];
                ss += v[0] * v[0] + v[1] * v[1] + v[2] * v[2] + v[3] * v[3]; *(u32x2*)(H2 + ((size_t)row * 2048 + col)) = pack4(v); }
            ss += __shfl_xor(ss, 16); ss += __shfl_xor(ss, 32);
            if (fq == 0) atomicAdd(ssq_o + row, ss);
        }
    }
};

struct EpiDownNorm {
    static constexpr bool MIDSCALE = false, PREFETCH = false;
    const bf16_t* XH; float* out; float* ssq_o; unsigned* cnt; const float* gain;
    __device__ __forceinline__ void operator()(EPI_ARGS) const {
        FOR_AI_M {
            const int row = u.pm * 256 + ai * 128 + wr * 64 + m * 16 + fr; float ss = 0.f;
            const bf16_t* hrow = XH + (size_t)((row >> 11) * XHB + (row & 2047) + 2) * 2048;
            FOR_BJ_N { const int col = u.pn * 256 + bj * 128 + wc * 32 + n * 16 + 4 * fq;
                const f32x4 v = unpack4(*(const u32x2*)(hrow + col)) + acc[ai][bj][m][n]; acc[ai][bj][m][n] = v;
                ss += v[0] * v[0] + v[1] * v[1] + v[2] * v[2] + v[3] * v[3]; }
            ss += __shfl_xor(ss, 16); ss += __shfl_xor(ss, 32);
            if (fq == 0) __hip_atomic_fetch_add(ssq_o + row, ss, __ATOMIC_RELAXED, __HIP_MEMORY_SCOPE_AGENT);
        }
        asm volatile("s_waitcnt vmcnt(0)" ::: "memory"); __builtin_amdgcn_s_barrier(); asm volatile("" ::: "memory");
        if (threadIdx.x == 0) {
            __builtin_amdgcn_fence(__ATOMIC_RELEASE, "agent");
            __hip_atomic_fetch_add(cnt + u.pm, 1u, __ATOMIC_RELAXED, __HIP_MEMORY_SCOPE_AGENT);
            unsigned sp = 0;
            while (__hip_atomic_load(cnt + u.pm, __ATOMIC_RELAXED, __HIP_MEMORY_SCOPE_AGENT) < 8u) { __builtin_amdgcn_s_sleep(1); if (++sp > (1u << 22)) break; }
            __builtin_amdgcn_fence(__ATOMIC_ACQUIRE, "agent");
            asm volatile("s_waitcnt vmcnt(0)" ::: "memory");
        }
        __builtin_amdgcn_s_barrier(); asm volatile("" ::: "memory");
        f32x4 gv[2][2];
#pragma unroll
        for (int bj = 0; bj < 2; ++bj)
#pragma unroll
            for (int n = 0; n < 2; ++n) gv[bj][n] = *(const f32x4*)(gain + u.pn * 256 + bj * 128 + wc * 32 + n * 16 + 4 * fq);
        FOR_AI_M {
            const int row = u.pm * 256 + ai * 128 + wr * 64 + m * 16 + fr;
            const float rs = rsqrtf(__hip_atomic_load(ssq_o + row, __ATOMIC_RELAXED, __HIP_MEMORY_SCOPE_AGENT) * (1.0f / 2048.0f) + EPS);
            FOR_BJ_N { const int col = u.pn * 256 + bj * 128 + wc * 32 + n * 16 + 4 * fq;
                __builtin_nontemporal_store(acc[ai][bj][m][n] * rs * gv[bj][n], (f32x4*)(out + ((size_t)row * 2048 + col))); }
        }
    }
};

__device__ __forceinline__ int sigma64(int p) { return (p >> 5) * 16 + (p & 15) + 32 * ((p >> 4) & 1); }

template <int WID>
__device__ __forceinline__ void transpose_tile(const Params& p, bf16_t* Wt, int K, int ldw, const float* W, int nt_, int kt_, LAS float* scr, int tid) {
    const int n0 = nt_ * 64, k0 = kt_ * 128;
    {
        const int c4 = (tid & 15) * 4; const int np = n0 + c4; int sc;
        if (WID == 0) { sc = np < 1792 ? np : (np < 1856 ? 1792 + sigma64(np - 1792) : -1); }
        else if (WID == 2) { const int h = np / 192, d = np - h * 192; sc = d < 128 ? np : h * 192 + 128 + sigma64(d - 128); }
        else if (WID == 5) { const int i32 = np & 31; const int jj = (np & 96) + 8 * ((i32 >> 2) & 3) + 4 * (i32 >> 4) + (i32 & 3); sc = ((np >> 7) & 1) * DFF + (np >> 8) * 128 + jj; }
        else sc = np;
        f32x4 v[4];
#pragma unroll
        for (int i = 0; i < 4; ++i) { const int kk = (tid >> 4) + 32 * i; v[i] = sc >= 0 ? __builtin_nontemporal_load((const f32x4*)(W + (size_t)(k0 + kk) * ldw + sc)) : (f32x4){0.f, 0.f, 0.f, 0.f}; }
#pragma unroll
        for (int i = 0; i < 4; ++i) {
            const int kk = (tid >> 4) + 32 * i; const int k = k0 + kk; float ksc = 1.0f;
            if (WID == 2) ksc = p.in[14][k];
            if (WID == 3) ksc = p.in[16][k];
            if (WID == 4) ksc = (k < 1024 ? p.in[18][k] : p.in[19][k - 1024]);
            if (WID == 5) ksc = p.in[21][k];
#pragma unroll
            for (int e = 0; e < 4; ++e) scr[kk * 65 + c4 + e] = v[i][e] * ksc;
        }
    }
    __syncthreads();
#pragma unroll
    for (int j = 0; j < 2; ++j) {
        const int idx = tid + 512 * j; const int r = idx >> 4, kg = (idx & 15) * 8; u32x4 w;
        w.x = cvt_pk(scr[(kg + 0) * 65 + r], scr[(kg + 1) * 65 + r]); w.y = cvt_pk(scr[(kg + 2) * 65 + r], scr[(kg + 3) * 65 + r]);
        w.z = cvt_pk(scr[(kg + 4) * 65 + r], scr[(kg + 5) * 65 + r]); w.w = cvt_pk(scr[(kg + 6) * 65 + r], scr[(kg + 7) * 65 + r]);
        *(u32x4*)(Wt + ((size_t)(n0 + r) * K + k0 + kg)) = w;
    }
    __syncthreads();
}

constexpr int KS_BYTES = 64 * 384, VS_BYTES = 128 * 128, KV_BYTES = KS_BYTES + VS_BYTES;
__device__ __forceinline__ int pi32(int r) { return (r & 0x13) | ((r & 4) << 1) | ((r & 8) >> 1); }

__device__ __forceinline__ void attn_unit(LAS unsigned char* lds, const bf16_t* Q, const bf16_t* KN, const bf16_t* KPE, const bf16_t* VT, bf16_t* Y, float* ssq_b, int b, int h, int qg) {
    const int tid = threadIdx.x, wid = __builtin_amdgcn_readfirstlane(tid >> 6), lane = tid & 63, q = lane & 31, hh = lane >> 5;
    const int t0 = 16 + 256 * qg, c0 = 1 + 4 * qg, cw = c0 + (wid >> 1), ntiles = c0 + 4;
    bf16x8 qf[12];
    {
        const bf16_t* qp = Q + (size_t)(b * 2048 + (t0 - 16) + 32 * wid + q) * 1536 + h * 192 + 8 * hh;
#pragma unroll
        for (int ks = 0; ks < 12; ++ks) qf[ks] = *(const bf16x8*)(qp + 16 * ks);
    }
    f32x16 o[4];
#pragma unroll
    for (int d = 0; d < 4; ++d)
#pragma unroll
        for (int i = 0; i < 16; ++i) o[d][i] = 0.f;
    float mrun = -INFINITY, lsum = 0.f;
    const char* ksrc[3]; unsigned kstr[3]; const char* vsrc[2];
#pragma unroll
    for (int i = 0; i < 3; ++i) {
        const int s = 64 * (wid * 3 + i) + lane; const int key = s / 24, pos = s - key * 24; const int pc = pos ^ ((key >> 1) & 7);
        const size_t row = (size_t)b * 2048 + key;
        if (pc < 16) { ksrc[i] = (const char*)(KN + row * 1024 + h * 128 + pc * 8); kstr[i] = 2048u; }
        else { ksrc[i] = (const char*)(KPE + row * 64 + (pc - 16) * 8); kstr[i] = 128u; }
    }
#pragma unroll
    for (int i = 0; i < 2; ++i) {
        const int s = 64 * (wid * 2 + i) + lane; const int d = s >> 3, pos = s & 7; const int pc = pos ^ ((d >> 1) & 7);
        vsrc[i] = (const char*)(VT + ((size_t)((b * 8 + h) * 128 + d)) * 2048 + pc * 8);
    }
#define AT_DMA(j) do { const int rowoff = (j) == 0 ? (16384 - b * 2048) : 64 * ((j) - 1); const size_t voff = (j) == 0 ? (size_t)(8 - b) * 8 * 128 * 2048 * 2 : (size_t)128 * ((j) - 1); LAS unsigned char* kb_ = lds + ((j) & 1) * KV_BYTES; \
        _Pragma("unroll") for (int i = 0; i < 3; ++i) __builtin_amdgcn_global_load_lds((const unsigned*)(ksrc[i] + (long)rowoff * (long)kstr[i]), (LAS unsigned*)(kb_ + (wid * 3 + i) * 1024), 16, 0, 0); \
        _Pragma("unroll") for (int i = 0; i < 2; ++i) __builtin_amdgcn_global_load_lds((const unsigned*)(vsrc[i] + voff), (LAS unsigned*)(kb_ + KS_BYTES + (wid * 2 + i) * 1024), 16, 0, 0); } while (0)
    const int key0 = pi32(q);
    const unsigned kbase0 = (unsigned)(key0 * 384) + (unsigned)(((hh ^ ((key0 >> 1) & 7))) << 4);
    const unsigned vbase0 = (unsigned)(q * 128) + (unsigned)((hh ^ ((q >> 1) & 7)) << 4);
    AT_DMA(0); __syncthreads();
    for (int j = 0; j < ntiles; ++j) {
        if (j + 1 < ntiles) AT_DMA(j + 1);
        if (j <= cw) {
            const LAS unsigned char* kb = lds + (j & 1) * KV_BYTES; const LAS unsigned char* vb = kb + KS_BYTES;
            f32x16 s0, s1;
#pragma unroll
            for (int i = 0; i < 16; ++i) { s0[i] = 0.f; s1[i] = 0.f; }
            __builtin_amdgcn_s_setprio(1);
            {
                bf16x8 a0n = *(const LAS bf16x8*)(kb + kbase0), a1n = *(const LAS bf16x8*)(kb + (kbase0 + 32u * 384u));
#pragma unroll
                for (int ks = 0; ks < 12; ++ks) {
                    const bf16x8 a0 = a0n, a1 = a1n;
                    if (ks + 1 < 12) { const unsigned off = (kbase0 ^ (unsigned)(((2 * (ks + 1)) & 7) << 4)) + (unsigned)(((2 * (ks + 1)) & 24) << 4);
                        a0n = *(const LAS bf16x8*)(kb + off); a1n = *(const LAS bf16x8*)(kb + (off + 32u * 384u)); }
                    s0 = __builtin_amdgcn_mfma_f32_32x32x16_bf16(a0, qf[ks], s0, 0, 0, 0);
                    s1 = __builtin_amdgcn_mfma_f32_32x32x16_bf16(a1, qf[ks], s1, 0, 0, 0);
                }
            }
            __builtin_amdgcn_s_setprio(0);
            if (j == 0) {
#pragma unroll
                for (int i = 0; i < 16; ++i) { if (i >= 8) s0[i] = -INFINITY; s1[i] = -INFINITY; }
            }
            float mx = s0[0];
#pragma unroll
            for (int i = 1; i < 16; ++i) mx = fmaxf(mx, s0[i]);
#pragma unroll
            for (int i = 0; i < 16; ++i) mx = fmaxf(mx, s1[i]);
            mx = fmaxf(mx, __shfl_xor(mx, 32));
            const bool upd = __builtin_amdgcn_ballot_w64(mx - mrun > 8.0f) != 0ull;
            const float mn = upd ? fmaxf(mrun, mx) : mrun; const float alpha = upd ? fexp2(mrun - mn) : 1.0f; mrun = mn;
            s0 = s0 - mn; s1 = s1 - mn;
#pragma unroll
            for (int i = 0; i < 16; ++i) { s0[i] = fexp2(s0[i]); s1[i] = fexp2(s1[i]); }
            const f32x16 t16 = s0 + s1;
            typedef float f32x8_ __attribute__((ext_vector_type(8)));
            const f32x8_ t8 = __builtin_shufflevector(t16, t16, 0, 1, 2, 3, 4, 5, 6, 7) + __builtin_shufflevector(t16, t16, 8, 9, 10, 11, 12, 13, 14, 15);
            const f32x4 t4 = __builtin_shufflevector(t8, t8, 0, 1, 2, 3) + __builtin_shufflevector(t8, t8, 4, 5, 6, 7);
            const float ps = (t4[0] + t4[1]) + (t4[2] + t4[3]);
            lsum = lsum * alpha + ps;
            if (upd) {
#pragma unroll
                for (int d = 0; d < 4; ++d)
#pragma unroll
                    for (int i = 0; i < 16; ++i) o[d][i] *= alpha;
            }
#pragma unroll
            for (int kb2 = 0; kb2 < 2; ++kb2)
#pragma unroll
                for (int a = 0; a < 2; ++a) {
                    u32x4 pw;
                    if (kb2 == 0) { pw.x = cvt_pk(s0[8 * a + 0], s0[8 * a + 1]); pw.y = cvt_pk(s0[8 * a + 2], s0[8 * a + 3]); pw.z = cvt_pk(s0[8 * a + 4], s0[8 * a + 5]); pw.w = cvt_pk(s0[8 * a + 6], s0[8 * a + 7]); }
                    else { pw.x = cvt_pk(s1[8 * a + 0], s1[8 * a + 1]); pw.y = cvt_pk(s1[8 * a + 2], s1[8 * a + 3]); pw.z = cvt_pk(s1[8 * a + 4], s1[8 * a + 5]); pw.w = cvt_pk(s1[8 * a + 6], s1[8 * a + 7]); }
                    const bf16x8 pf = __builtin_bit_cast(bf16x8, pw);
                    const unsigned vro = vbase0 ^ (unsigned)((4 * kb2 + 2 * a) << 4);
                    __builtin_amdgcn_s_setprio(1);
#pragma unroll
                    for (int db = 0; db < 4; ++db) {
                        const bf16x8 vf = *(const LAS bf16x8*)(vb + (vro + (unsigned)(db * 4096)));
                        o[db] = __builtin_amdgcn_mfma_f32_32x32x16_bf16(vf, pf, o[db], 0, 0, 0);
                    }
                    __builtin_amdgcn_s_setprio(0);
                }
        }
        __syncthreads();
    }
    {
        const float lt = lsum + __shfl_xor(lsum, 32); const float inv = 1.0f / lt;
        const size_t row = (size_t)b * 2048 + (t0 - 16) + 32 * wid + q; float ss = 0.f;
#pragma unroll
        for (int db = 0; db < 4; ++db)
#pragma unroll
            for (int jj = 0; jj < 4; ++jj) {
                f32x4 v; v[0] = o[db][4 * jj] * inv; v[1] = o[db][4 * jj + 1] * inv; v[2] = o[db][4 * jj + 2] * inv; v[3] = o[db][4 * jj + 3] * inv;
                ss += v[0] * v[0] + v[1] * v[1] + v[2] * v[2] + v[3] * v[3];
                *(u32x2*)(Y + (row * 2048 + 1024 + h * 128 + 32 * db + 8 * jj + 4 * hh)) = pack4(v);
            }
        ss += __shfl_xor(ss, 32);
        if (hh == 0 && ssq_b) atomicAdd(ssq_b + row, ss);
    }
#undef AT_DMA
}

__device__ __forceinline__ float dot8(u32x4 a, u32x4 k) {
    return __builtin_bit_cast(float, a.x << 16) * __builtin_bit_cast(float, k.x << 16) + __builtin_bit_cast(float, a.x & 0xffff0000u) * __builtin_bit_cast(float, k.x & 0xffff0000u)
         + __builtin_bit_cast(float, a.y << 16) * __builtin_bit_cast(float, k.y << 16) + __builtin_bit_cast(float, a.y & 0xffff0000u) * __builtin_bit_cast(float, k.y & 0xffff0000u)
         + __builtin_bit_cast(float, a.z << 16) * __builtin_bit_cast(float, k.z << 16) + __builtin_bit_cast(float, a.z & 0xffff0000u) * __builtin_bit_cast(float, k.z & 0xffff0000u)
         + __builtin_bit_cast(float, a.w << 16) * __builtin_bit_cast(float, k.w << 16) + __builtin_bit_cast(float, a.w & 0xffff0000u) * __builtin_bit_cast(float, k.w & 0xffff0000u);
}
__device__ __forceinline__ void attn_meta(LAS unsigned char* lds, const bf16_t* Q, const bf16_t* KN, const bf16_t* KPE, const bf16_t* VT, bf16_t* Y, float* ssq_b, int b, int h) {
    const int tid = threadIdx.x; LAS float* sc = (LAS float*)lds;
    if (tid < 256) {
        const int qi = tid >> 7, k = (tid >> 3) & 15, part = tid & 7;
        const size_t qrow = (size_t)16384 + 14 + qi, krow = (size_t)16384 + k; float acc = 0.f;
#pragma unroll
        for (int i = 0; i < 3; ++i) { const int pc = part * 3 + i;
            const u32x4 qw = *(const u32x4*)(Q + qrow * 1536 + h * 192 + pc * 8);
            const u32x4 kw = pc < 16 ? *(const u32x4*)(KN + krow * 1024 + h * 128 + pc * 8) : *(const u32x4*)(KPE + krow * 64 + (pc - 16) * 8);
            acc += dot8(qw, kw); }
        acc += __shfl_xor(acc, 1); acc += __shfl_xor(acc, 2); acc += __shfl_xor(acc, 4);
        if (part == 0) sc[qi * 16 + k] = acc;
    }
    __syncthreads();
    if (tid < 256) {
        const int qi = tid >> 7, d = tid & 127; const size_t row = (size_t)16384 + qi;
        float s[16]; float mx = -INFINITY;
#pragma unroll
        for (int k = 0; k < 16; ++k) { s[k] = sc[qi * 16 + k]; mx = fmaxf(mx, s[k]); }
        float l = 0.f;
#pragma unroll
        for (int k = 0; k < 16; ++k) { s[k] = fexp2(s[k] - mx); l += s[k]; }
        const bf16_t* vp = VT + ((size_t)((64 + h) * 128 + d)) * 2048;
        const u32x4 va = *(const u32x4*)vp, vb = *(const u32x4*)(vp + 8);
        float a = s[0] * __builtin_bit_cast(float, va.x << 16) + s[1] * __builtin_bit_cast(float, va.x & 0xffff0000u) + s[2] * __builtin_bit_cast(float, va.y << 16) + s[3] * __builtin_bit_cast(float, va.y & 0xffff0000u)
                + s[4] * __builtin_bit_cast(float, va.z << 16) + s[5] * __builtin_bit_cast(float, va.z & 0xffff0000u) + s[6] * __builtin_bit_cast(float, va.w << 16) + s[7] * __builtin_bit_cast(float, va.w & 0xffff0000u)
                + s[8] * __builtin_bit_cast(float, vb.x << 16) + s[9] * __builtin_bit_cast(float, vb.x & 0xffff0000u) + s[10] * __builtin_bit_cast(float, vb.y << 16) + s[11] * __builtin_bit_cast(float, vb.y & 0xffff0000u)
                + s[12] * __builtin_bit_cast(float, vb.z << 16) + s[13] * __builtin_bit_cast(float, vb.z & 0xffff0000u) + s[14] * __builtin_bit_cast(float, vb.w << 16) + s[15] * __builtin_bit_cast(float, vb.w & 0xffff0000u);
        a = a / l;
        Y[row * 2048 + 1024 + h * 128 + d] = (bf16_t)(cvt_pk(a, 0.f) & 0xffff);
        const float ss = wave_sum(a * a);
        if ((tid & 63) == 0 && ssq_b) atomicAdd(ssq_b + row, ss);
    }
    __syncthreads();
}


#define XB_TMO      128
#define XB_XCNT(j)  (256  + 64 * (j))
#define XB_XSUB(j)  (1280 + 64 * (j))
#define XB_XGEN(j)  (2304 + 64 * (j))
#define XB_TOP      3328
#define XB_TOPGEN   3392
#define XCD_BAR_WORDS 3456
#define XB_SPIN_CAP (1u << 18)
__device__ __forceinline__ unsigned xb_ld(unsigned* p)              { return __hip_atomic_load(p, __ATOMIC_RELAXED, __HIP_MEMORY_SCOPE_AGENT); }
__device__ __forceinline__ unsigned xb_add(unsigned* p, unsigned v) { return __hip_atomic_fetch_add(p, v, __ATOMIC_RELAXED, __HIP_MEMORY_SCOPE_AGENT); }
__device__ __forceinline__ unsigned xb_xcc_id() { return (unsigned)__builtin_amdgcn_s_getreg((3 << 11) | 20) & 0xFu; }
#define XB_SPIN(cond, bar) do { unsigned _sp = 0; while (cond) { __builtin_amdgcn_s_sleep(1); \
    if ((++_sp & 255u) == 0u) { if (xb_ld(&(bar)[XB_TMO])) break; if (_sp > XB_SPIN_CAP) { atomicAdd(&(bar)[XB_TMO], 1u); break; } } } } while (0)
struct XcdBarrier { unsigned* bar; unsigned x; volatile LAS unsigned* st; };
__device__ __forceinline__ XcdBarrier xcd_barrier_post(unsigned* bar, volatile LAS unsigned* st) {
    XcdBarrier b; b.bar = bar; b.x = xb_xcc_id(); b.st = st;
    if (threadIdx.x == 0) (void)xb_add(&bar[XB_XCNT(b.x)], 1u);
    return b;
}
__device__ __forceinline__ void xcd_barrier_complete(unsigned* bar, unsigned x, unsigned& nloc, unsigned& nx) {
    const unsigned G = gridDim.x * gridDim.y * gridDim.z;
    unsigned sum, cnt, mine, sp = 0u;
    for (;;) {
        sum = 0u; cnt = 0u; mine = 0u;
#pragma unroll
        for (unsigned j = 0; j < 16; ++j) { const unsigned c = xb_ld(&bar[XB_XCNT(j)]); sum += c; cnt += (c > 0u) ? 1u : 0u; mine = (j == x) ? c : mine; }
        if (sum == G) break;
        __builtin_amdgcn_s_sleep(1);
        if ((++sp & 255u) == 0u) { if (xb_ld(&bar[XB_TMO])) break; if (sp > XB_SPIN_CAP) { atomicAdd(&bar[XB_TMO], 1u); break; } }
    }
    nloc = mine > 0u ? mine : 1u; nx = cnt > 0u ? cnt : 1u;
}
__device__ __forceinline__ void xcd_barrier(const XcdBarrier& b) {
    asm volatile("s_waitcnt vmcnt(0)" ::: "memory");
    __syncthreads();
    if (threadIdx.x == 0) {
        unsigned* bar = b.bar;
        __builtin_amdgcn_s_waitcnt(0);
        unsigned nloc = b.st[0], nx = b.st[1];
        if (nloc == 0u) { xcd_barrier_complete(bar, b.x, nloc, nx); b.st[0] = nloc; b.st[1] = nx; }
        const unsigned old = xb_add(&bar[XB_XSUB(b.x)], 1u);
        const unsigned gen = old / nloc;
        if (old + 1u == (gen + 1u) * nloc) {
            __builtin_amdgcn_fence(__ATOMIC_RELEASE, "agent");
            asm volatile("s_waitcnt vmcnt(0)" ::: "memory");
            const unsigned og = xb_add(&bar[XB_TOP], 1u);
            const unsigned tg = og / nx;
            if (og + 1u == (tg + 1u) * nx) xb_add(&bar[XB_TOPGEN], 1u);
            else XB_SPIN(xb_ld(&bar[XB_TOPGEN]) == tg, bar);
            __builtin_amdgcn_fence(__ATOMIC_ACQUIRE, "agent");
            xb_add(&bar[XB_XGEN(b.x)], 1u);
            asm volatile("s_waitcnt vmcnt(0)" ::: "memory");
        } else {
            XB_SPIN(xb_ld(&bar[XB_XGEN(b.x)]) == gen, bar);
            __builtin_amdgcn_fence(__ATOMIC_ACQUIRE, "agent");
            asm volatile("s_waitcnt vmcnt(0)" ::: "memory");
        }
    }
    __syncthreads();
}

__global__ void __launch_bounds__(NTHR, 2) fwd_megakernel(Params p) {
    extern __shared__ __attribute__((aligned(16))) unsigned char smem[];
    LAS unsigned char* lds = (LAS unsigned char*)smem;
    cg::grid_group grid = cg::this_grid();
    const int tid = threadIdx.x, lane = tid & 63, wid = tid >> 6, G = gridDim.x, bid = blockIdx.x;
    const long gtid = (long)bid * NTHR + tid, gthreads = (long)G * NTHR;
    unsigned char* ws = p.ws;
    bf16_t* WinT = (bf16_t*)(ws + O_WIN); bf16_t* WgluT = (bf16_t*)(ws + O_WGLU); bf16_t* WqT = (bf16_t*)(ws + O_WQ); bf16_t* WkvT = (bf16_t*)(ws + O_WKV);
    bf16_t* WoutT = (bf16_t*)(ws + O_WOUT); bf16_t* WupT = (bf16_t*)(ws + O_WUP); bf16_t* WdT = (bf16_t*)(ws + O_WD);
    bf16_t* MST = (bf16_t*)(ws + O_MST); bf16_t* MIO = (bf16_t*)(ws + O_MIO); float* KD = (float*)(ws + O_KD);
    float2* PWC = (float2*)(ws + O_PWC); float2* PW1 = (float2*)(ws + O_PW1); float* COS = (float*)(ws + O_COS); float* SIN = (float*)(ws + O_SIN);
    float* ssq_q = (float*)(ws + O_SSQ); float* ssq_kv = ssq_q + MPAD; float* ssq_a = ssq_kv + MPAD; float* ssq_b = ssq_a + MPAD; float* ssq_h = ssq_b + MPAD; float* ssq_o = ssq_h + MPAD; float* rinvx = ssq_o + MPAD;
    bf16_t* Y = (bf16_t*)(ws + O_Y); bf16_t* XN = (bf16_t*)(ws + O_XN); bf16_t* XS = (bf16_t*)(ws + O_XS); bf16_t* QA = (bf16_t*)(ws + O_QA); bf16_t* KVA = (bf16_t*)(ws + O_KVA);
    bf16_t* KPE = (bf16_t*)(ws + O_KPE); bf16_t* Qb = (bf16_t*)(ws + O_Q); bf16_t* KN = (bf16_t*)(ws + O_KN); bf16_t* VT = (bf16_t*)(ws + O_VT); float* Sst = (float*)(ws + O_S);
    bf16_t* Gb = (bf16_t*)(ws + O_G); bf16_t* XH = (bf16_t*)(ws + O_XH); bf16_t* ACT = (bf16_t*)(ws + O_ACT);
    const float* x = p.in[0]; const float* meta = p.in[1];
    unsigned* barw = (unsigned*)(ws + O_BAR);
    volatile LAS unsigned* bst = (volatile LAS unsigned*)(lds + STAGE_BYTES + 16384);
    if (tid < 4) bst[tid] = 0u;
    __syncthreads();
    XcdBarrier xbar; xbar.bar = barw; xbar.x = 0; xbar.st = bst;

#if PH_ON(0)
#pragma unroll 1
    for (int rep = 0; rep < 1 + DUP_ON(0); ++rep)
    {
        for (long i = gtid; i < 6 * MPAD; i += gthreads) ssq_q[i] = 0.f;
        if (bid == 0) for (int i = tid; i < 4096; i += NTHR) barw[i] = 0u;
        for (long i = gtid; i < 1024 * 6; i += gthreads) { const int r = (int)(i / 6), pc = (int)(i % 6); *(u32x4*)(VT + ((size_t)(64 * 128 + r)) * 2048 + 16 + pc * 8) = (u32x4){0u, 0u, 0u, 0u}; }
        for (long i = gtid; i < LL * 32; i += gthreads) { const int pos = (int)(i >> 5), j = (int)(i & 31); const float invf = 1.0f / powf(10000.0f, (float)(2 * j) / 64.0f); const float ang = (float)pos * invf; COS[i] = cosf(ang); SIN[i] = sinf(ang); }
        for (long idx = gtid; idx < 4096 * 16; idx += gthreads) {
            const long i = idx >> 4; const int d = (int)(idx & 15); const int g = (int)(i >> 6);
            const float lr = p.in[4][i], li = p.in[5][i], dt = expf(p.in[6][g]); const float zr = lr * dt, zi = li * dt;
            const float er = expf(zr); const float lbr = er * cosf(zi), lbi = er * sinf(zi);
            const float nr = lbr - 1.0f, ni = lbi, den = lr * lr + li * li;
            const float cr = (nr * lr + ni * li) / den, ci = (ni * lr - nr * li) / den;
            const float e0 = expf(zr * (float)d), a0 = zi * (float)d; const float pr = e0 * cosf(a0), pi = e0 * sinf(a0);
            PWC[idx] = make_float2(pr * cr - pi * ci, pr * ci + pi * cr);
            const float e1 = expf(zr * (float)(d + 1)), a1 = zi * (float)(d + 1);
            PW1[idx] = make_float2(e1 * cosf(a1), e1 * sinf(a1));
        }
        for (int row = bid * 8 + wid; row < 16384 + NMETA; row += G * 8) {
            bf16_t* orow = XN + (size_t)row * 2048;
            const float* hrow = (row >= 16384) ? meta + (size_t)(row - 16384) * 2048 : x + (size_t)row * 2048;
            f32x4 v[8]; float ss = 0.f;
#pragma unroll
            for (int i = 0; i < 4; ++i) { v[2 * i] = __builtin_nontemporal_load((const f32x4*)(hrow + i * 512 + lane * 8)); v[2 * i + 1] = __builtin_nontemporal_load((const f32x4*)(hrow + i * 512 + lane * 8 + 4)); }
#pragma unroll
            for (int i = 0; i < 8; ++i) ss += v[i][0] * v[i][0] + v[i][1] * v[i][1] + v[i][2] * v[i][2] + v[i][3] * v[i][3];
            ss = wave_sum(ss); const float rs = rsqrtf(ss * (1.0f / 2048.0f) + EPS);
            if (lane == 0) rinvx[row] = 1.0f / rs;
#pragma unroll
            for (int i = 0; i < 4; ++i) {
                const f32x4 g0 = *(const f32x4*)(p.in[2] + i * 512 + lane * 8), g1 = *(const f32x4*)(p.in[2] + i * 512 + lane * 8 + 4);
                const f32x4 a = v[2 * i] * rs * g0, c = v[2 * i + 1] * rs * g1; u32x4 w; w.x = cvt_pk(a[0], a[1]); w.y = cvt_pk(a[2], a[3]); w.z = cvt_pk(c[0], c[1]); w.w = cvt_pk(c[2], c[3]);
                *(u32x4*)(orow + i * 512 + lane * 8) = w;
            }
        }
        LAS float* scr = (LAS float*)lds;
        constexpr int T0 = 32 * 16, T1 = T0 + 16 * 8, T2 = T1 + 24 * 4, T3 = T2 + 32 * 2, T4 = T3 + 32 * 16, T5 = T4 + 172 * 16, T6 = T5 + 32 * 43;
        for (int it = bid; it < T6; it += G) {
            if (it < T0) { transpose_tile<0>(p, WinT, 2048, 1856, p.in[3], it % 32, it / 32, scr, tid); }
            else if (it < T1) { const int j = it - T0; transpose_tile<1>(p, WgluT, 1024, 1024, p.in[12], j % 16, j / 16, scr, tid); }
            else if (it < T2) { const int j = it - T1; transpose_tile<2>(p, WqT, 512, 1536, p.in[15], j % 24, j / 24, scr, tid); }
            else if (it < T3) { const int j = it - T2; transpose_tile<3>(p, WkvT, 256, 2048, p.in[17], j % 32, j / 32, scr, tid); }
            else if (it < T4) { const int j = it - T3; transpose_tile<4>(p, WoutT, 2048, 2048, p.in[20], j % 32, j / 32, scr, tid); }
            else if (it < T5) { const int j = it - T4; transpose_tile<5>(p, WupT, 2048, 2 * DFF, p.in[22], j % 172, j / 172, scr, tid); }
            else { const int j = it - T5; transpose_tile<6>(p, WdT, DFF, 2048, p.in[25], j % 32, j / 32, scr, tid); }
        }
    grid.sync();
    if (rep == 0) xbar = xcd_barrier_post(barw, bst);
    }

#endif
#if PH_ON(1)
#pragma unroll 1
    for (int rep = 0; rep < 1 + DUP_ON(1); ++rep)
    {
        const float* b_re = p.in[7]; const float* b_im = p.in[8]; const float* c_re = p.in[9]; const float* c_im = p.in[10];
        {
            LAS float* Bre = (LAS float*)lds; LAS float* Bim = Bre + 1024; LAS float* Cre = Bim + 1024; LAS float* Cim = Cre + 1024; LAS float* Wre = Cim + 1024; LAS float* Wim = Wre + 256;
            for (int wi = bid; wi < 256; wi += G) {
                const int g = wi >> 2, dq = wi & 3;
                if (tid < 256) {
                    ((LAS f32x4*)Bre)[tid] = ((const f32x4*)(b_re + g * 1024))[tid]; ((LAS f32x4*)Bim)[tid] = ((const f32x4*)(b_im + g * 1024))[tid];
                    ((LAS f32x4*)Cre)[tid] = ((const f32x4*)(c_re + g * 1024))[tid]; ((LAS f32x4*)Cim)[tid] = ((const f32x4*)(c_im + g * 1024))[tid];
                    const int q = tid & 63, dd = tid >> 6; const float2 w = PWC[(g * 64 + q) * 16 + 4 * dq + dd]; Wre[dd * 64 + q] = w.x; Wim[dd * 64 + q] = w.y;
                }
                __syncthreads();
#pragma unroll
                for (int j = 0; j < 2; ++j) {
                    const int o = tid + 512 * j, dd = o >> 8, c = (o >> 4) & 15, c2 = o & 15; float acc = 0.f;
#pragma unroll 8
                    for (int q = 0; q < 64; ++q) {
                        const float cr = Cre[c * 64 + q], ci = Cim[c * 64 + q], wr_ = Wre[dd * 64 + q], wi_ = Wim[dd * 64 + q];
                        const float tr = cr * wr_ - ci * wi_, ti = cr * wi_ + ci * wr_;
                        acc += tr * Bre[q * 16 + c2] - ti * Bim[q * 16 + c2];
                    }
                    KD[((g * 16 + 4 * dq + dd) * 16 + c) * 16 + c2] = acc;
                }
                __syncthreads();
            }
        }
        for (long i = gtid; i < (long)64 * 256 * 8; i += gthreads) {
            const int g = (int)(i >> 11), n = (int)(i >> 3) & 255, sp = (int)i & 7;
            u32x4 o[4];
#pragma unroll
            for (int e = 0; e < 4; ++e) o[e] = (u32x4){0u, 0u, 0u, 0u};
            if (n < 128) {
                const int q = n & 63; const float2 w0 = PWC[(g * 64 + q) * 16 + (15 - 2 * sp)], w1 = PWC[(g * 64 + q) * 16 + (14 - 2 * sp)];
                const float* brp = b_re + (g * 64 + q) * 16; const float* bip = b_im + (g * 64 + q) * 16; f32x4 br[4], bi[4];
#pragma unroll
                for (int e = 0; e < 4; ++e) { br[e] = *(const f32x4*)(brp + 4 * e); bi[e] = *(const f32x4*)(bip + 4 * e); }
#pragma unroll
                for (int h2 = 0; h2 < 2; ++h2) { const float2 w = h2 ? w1 : w0; float v[16];
#pragma unroll
                    for (int e = 0; e < 16; ++e) { const float a = br[e >> 2][e & 3], bq = bi[e >> 2][e & 3]; v[e] = (n < 64) ? (w.x * a - w.y * bq) : (w.x * bq + w.y * a); }
                    o[2 * h2].x = cvt_pk(v[0], v[1]); o[2 * h2].y = cvt_pk(v[2], v[3]); o[2 * h2].z = cvt_pk(v[4], v[5]); o[2 * h2].w = cvt_pk(v[6], v[7]);
                    o[2 * h2 + 1].x = cvt_pk(v[8], v[9]); o[2 * h2 + 1].y = cvt_pk(v[10], v[11]); o[2 * h2 + 1].z = cvt_pk(v[12], v[13]); o[2 * h2 + 1].w = cvt_pk(v[14], v[15]); }
            }
            u32x4* dst = (u32x4*)(MST + ((size_t)(g * 256 + n) * 256 + sp * 32));
#pragma unroll
            for (int e = 0; e < 4; ++e) dst[e] = o[e];
        }
        for (long i = gtid; i < (long)64 * 256 * 8; i += gthreads) {
            const int g = (int)(i >> 11), n = (int)(i >> 3) & 255, j = (int)i & 7; const int kk0 = 16 * j, q0 = kk0 & 63, t = n >> 4, c = n & 15; const bool neg = kk0 >= 64;
            const float* crp = c_re + (g * 16 + c) * 64 + q0; const float* cip = c_im + (g * 16 + c) * 64 + q0;
            f32x4 cr[4], ci[4]; float2 w[16];
#pragma unroll
            for (int e = 0; e < 4; ++e) { cr[e] = *(const f32x4*)(crp + 4 * e); ci[e] = *(const f32x4*)(cip + 4 * e); }
#pragma unroll
            for (int e = 0; e < 16; ++e) w[e] = PW1[(g * 64 + q0 + e) * 16 + t];
            float v[16];
#pragma unroll
            for (int e = 0; e < 16; ++e) { const float a = cr[e >> 2][e & 3], bq = ci[e >> 2][e & 3]; v[e] = neg ? -(a * w[e].y + bq * w[e].x) : (a * w[e].x - bq * w[e].y); }
            u32x4 o0, o1; o0.x = cvt_pk(v[0], v[1]); o0.y = cvt_pk(v[2], v[3]); o0.z = cvt_pk(v[4], v[5]); o0.w = cvt_pk(v[6], v[7]);
            o1.x = cvt_pk(v[8], v[9]); o1.y = cvt_pk(v[10], v[11]); o1.z = cvt_pk(v[12], v[13]); o1.w = cvt_pk(v[14], v[15]);
            u32x4* dst = (u32x4*)(MIO + ((size_t)(g * 256 + n) * XSK + 256 + kk0)); dst[0] = o0; dst[1] = o1;
        }
        {
            LAS f32x4* red = (LAS f32x4*)lds;
            const int fr = lane & 15, fq = lane >> 4;
            for (int task = bid; task < 114; task += G) {
                const bool pair = task >= 112;
                const int g0 = pair ? 112 + 2 * (task - 112) : task;
                f32x4 c0 = (f32x4){0.f, 0.f, 0.f, 0.f}, c1 = c0;
#pragma unroll
                for (int i = 0; i < 8; ++i) {
                    const int k = wid * 256 + i * 32 + 8 * fq;
                    const bf16x8 af = *(const bf16x8*)(XN + (size_t)(16384 + fr) * 2048 + k);
                    const bf16x8 b0 = *(const bf16x8*)(WinT + (size_t)(g0 * 16 + fr) * 2048 + k);
                    c0 = __builtin_amdgcn_mfma_f32_16x16x32_bf16(b0, af, c0, 0, 0, 0);
                    if (pair) { const bf16x8 b1 = *(const bf16x8*)(WinT + (size_t)(g0 * 16 + 16 + fr) * 2048 + k); c1 = __builtin_amdgcn_mfma_f32_16x16x32_bf16(b1, af, c1, 0, 0, 0); }
                }
                red[wid * 64 + lane] = c0; red[512 + wid * 64 + lane] = c1;
                __syncthreads();
                if (wid == 0) {
                    f32x4 v0 = red[lane], v1 = red[512 + lane];
#pragma unroll
                    for (int w2 = 1; w2 < 8; ++w2) { v0 += red[w2 * 64 + lane]; v1 += red[512 + w2 * 64 + lane]; }
                    const int t = fr;
                    if (g0 < 64) { *(u32x2*)(XS + ((size_t)(g0 * GRP + 1024)) * XSK + t * 16 + 4 * fq) = pack4(v0); }
                    else if (g0 < 112) {
                        float ss = v0[0] * v0[0] + v0[1] * v0[1] + v0[2] * v0[2] + v0[3] * v0[3];
                        if (g0 < 96) *(u32x2*)(QA + (size_t)(16384 + t) * 512 + (g0 - 64) * 16 + 4 * fq) = pack4(v0);
                        else *(u32x2*)(KVA + (size_t)(16384 + t) * 256 + (g0 - 96) * 16 + 4 * fq) = pack4(v0);
                        ss += __shfl_xor(ss, 16); ss += __shfl_xor(ss, 32);
                        if (fq == 0) atomicAdd((g0 < 96 ? ssq_q : ssq_kv) + 16384 + t, ss);
                    } else {
                        const int pp = 32 * (task - 112) + 4 * fq, j = 16 * (task - 112) + 4 * fq;
                        const f32x4 c = *(const f32x4*)(COS + t * 32 + j), sn_ = *(const f32x4*)(SIN + t * 32 + j); f32x4 y1, y2;
#pragma unroll
                        for (int e = 0; e < 4; ++e) { y1[e] = v0[e] * c[e] - v1[e] * sn_[e]; y2[e] = v1[e] * c[e] + v0[e] * sn_[e]; }
                        *(u32x2*)(KPE + (size_t)(16384 + t) * 64 + pp) = pack4(y1); *(u32x2*)(KPE + (size_t)(16384 + t) * 64 + pp + 16) = pack4(y2);
                    }
                }
                __syncthreads();
            }
        }
        GSched<0> S; S.init(XN, WinT, 2048, 2048, 64, 8, 1, 0, 0);
        EpiZ E{XS, QA, KVA, KPE, rep ? nullptr : ssq_q, ssq_kv, COS, SIN};
        gemm_phase(lds, S, E);
    xcd_barrier(xbar);
    }

#endif
#if PH_ON(2)
    {
        for (long i = gtid; i < (long)64 * 256 * 16; i += gthreads) {
            const int g = (int)(i >> 12), n = (int)(i >> 4) & 255, sx = (int)i & 15; const int t = n >> 4, c = n & 15;
            u32x4 o0 = (u32x4){0u, 0u, 0u, 0u}, o1 = o0;
            if (sx <= t) { const float* kp = KD + ((g * 16 + (t - sx)) * 16 + c) * 16; const f32x4 a0 = *(const f32x4*)kp, a1 = *(const f32x4*)(kp + 4), a2 = *(const f32x4*)(kp + 8), a3 = *(const f32x4*)(kp + 12);
                o0.x = cvt_pk(a0[0], a0[1]); o0.y = cvt_pk(a0[2], a0[3]); o0.z = cvt_pk(a1[0], a1[1]); o0.w = cvt_pk(a1[2], a1[3]);
                o1.x = cvt_pk(a2[0], a2[1]); o1.y = cvt_pk(a2[2], a2[3]); o1.z = cvt_pk(a3[0], a3[1]); o1.w = cvt_pk(a3[2], a3[3]); }
            u32x4* dst = (u32x4*)(MIO + ((size_t)(g * 256 + n) * XSK + sx * 16)); dst[0] = o0; dst[1] = o1;
        }
        for (int col = bid * 8 + wid; col < 2048; col += G * 8) {
            const u32x2 w = *(const u32x2*)(WkvT + (size_t)col * 256 + lane * 4); float v = 0.f;
#pragma unroll
            for (int r = 0; r < 16; ++r) { const float s_ = wave_sum(dot4(*(const u32x2*)(KVA + (size_t)(16384 + r) * 256 + lane * 4), w)); if (lane == r) v = s_; }
            if (lane < 16) { v *= rsqrtf(ssq_kv[16384 + lane] * (1.0f / 256.0f) + EPS); const int hd = col >> 8, wi = col & 255;
                if (wi < 128) KN[(size_t)(16384 + lane) * 1024 + hd * 128 + wi] = f2bf(v); else VT[((size_t)((64 + hd) * 128 + wi - 128)) * 2048 + lane] = f2bf(v); }
        }
        for (int task = bid * 8 + wid; task < 1280; task += G * 8) {
            const bool pair = task >= 1024; int n0, n1, j = 0;
            if (!pair) { n0 = 192 * (task >> 7) + (task & 127); n1 = n0; }
            else { const int pidx = task - 1024, hq = pidx >> 5, pq = pidx & 31, pp = (pq >> 4) * 32 + (pq & 15); n0 = 192 * hq + 128 + pp; n1 = n0 + 16; j = (pp >> 5) * 16 + (pp & 15); }
            const u32x4 w0 = *(const u32x4*)(WqT + (size_t)n0 * 512 + lane * 8), w1 = *(const u32x4*)(WqT + (size_t)n1 * 512 + lane * 8);
            const u32x4 x0 = *(const u32x4*)(QA + (size_t)(16384 + 14) * 512 + lane * 8), x1 = *(const u32x4*)(QA + (size_t)(16384 + 15) * 512 + lane * 8);
            const float p00 = wave_sum(dot8(x0, w0)), p01 = wave_sum(dot8(x0, w1)), p10 = wave_sum(dot8(x1, w0)), p11 = wave_sum(dot8(x1, w1));
            if (lane < 2) { const int t = 14 + lane; const float rs = rsqrtf(ssq_q[16384 + t] * (1.0f / 512.0f) + EPS) * QSCALE;
                float y0 = (lane ? p10 : p00) * rs, y1 = (lane ? p11 : p01) * rs;
                if (pair) { const float c = COS[t * 32 + j], sn_ = SIN[t * 32 + j]; const float z0 = y0 * c - y1 * sn_, z1 = y1 * c + y0 * sn_; y0 = z0; y1 = z1; }
                Qb[(size_t)(16384 + t) * 1536 + n0] = f2bf(y0); if (pair) Qb[(size_t)(16384 + t) * 1536 + n1] = f2bf(y1); }
        }
        for (int t4 = (bid * 8 + wid) * 4; t4 < 64 * 128; t4 += G * 32) {
            const int g = t4 >> 7, n0_ = t4 & 127;
            const u32x2 xv = *(const u32x2*)(XS + ((size_t)(g * GRP + 1024)) * XSK + lane * 4);
            u32x2 mv[4];
#pragma unroll
            for (int i = 0; i < 4; ++i) mv[i] = *(const u32x2*)(MST + ((size_t)(g * 256 + n0_ + i)) * 256 + lane * 4);
            float r4[4];
#pragma unroll
            for (int i = 0; i < 4; ++i) r4[i] = wave_sum(dot4(xv, mv[i]));
            if (lane == 0) *(f32x4*)(Sst + ((size_t)(g * GRP + 1024)) * 128 + n0_) = (f32x4){r4[0], r4[1], r4[2], r4[3]};
        }
        { GSched<0> S; S.init(QA, WqT, 512, 512, 64, 6, 1, 0, 0); EpiQ E{Qb, ssq_q, COS, SIN}; gemm_phase(lds, S, E); }
        { GSched<0> S; S.init(KVA, WkvT, 256, 256, 64, 8, 1, 0, 0); EpiKV E{KN, VT, ssq_kv}; gemm_phase(lds, S, E); }
        { GSched<0> S; S.init(XS, MST, XSK, 256, 4, 1, 64, (size_t)GRP * XSK * 2, (size_t)256 * 256 * 2); EpiS E{Sst}; gemm_phase(lds, S, E); }
    }
    xcd_barrier(xbar);

#endif
#if PH_ON(3)
#pragma unroll 1
    for (int rep = 0; rep < 1 + DUP_ON(3); ++rep)
    {
        float* ssq_b_ = rep ? nullptr : ssq_b;
#ifndef NO_SCAN
        {
            LAS float* tb = (LAS float*)lds;
            for (int base = bid * 128; base < NB * 64 * 64; base += G * 128) {
                const int cl = tid & 127, seg = tid >> 7, ch = base + cl;
                const int q = ch & 63, g = (ch >> 6) & 63, b = ch >> 12;
                const float2 l16 = PW1[(g * 64 + q) * 16 + 15];
                const float* sp = Sst + ((size_t)(g * GRP + b * 128 + 32 * seg)) * 128 + q; bf16_t* xp = XS + ((size_t)(g * GRP + b * 128 + 32 * seg)) * XSK + 256 + q;
                float sr[32], si[32];
#pragma unroll
                for (int k = 0; k < 32; ++k) { sr[k] = sp[(size_t)k * 128]; si[k] = sp[(size_t)k * 128 + 64]; }
                float hr = 0.f, hi = 0.f;
#pragma unroll
                for (int k = 0; k < 32; ++k) { const float nr = l16.x * hr - l16.y * hi + sr[k], ni = l16.x * hi + l16.y * hr + si[k]; hr = nr; hi = ni; }
                tb[(seg * 128 + cl) * 2] = hr; tb[(seg * 128 + cl) * 2 + 1] = hi;
                __syncthreads();
                float pr = l16.x, pi = l16.y;
#pragma unroll
                for (int e = 0; e < 5; ++e) { const float nr = pr * pr - pi * pi, ni = 2.0f * pr * pi; pr = nr; pi = ni; }
                hr = Sst[((size_t)(g * GRP + 1024)) * 128 + q]; hi = Sst[((size_t)(g * GRP + 1024)) * 128 + 64 + q];
#pragma unroll
                for (int s2 = 0; s2 < 3; ++s2) { if (s2 < seg) { const float t2x = tb[(s2 * 128 + cl) * 2], t2y = tb[(s2 * 128 + cl) * 2 + 1]; const float nr = pr * hr - pi * hi + t2x, ni = pr * hi + pi * hr + t2y; hr = nr; hi = ni; } }
#pragma unroll
                for (int k = 0; k < 32; ++k) {
                    xp[(size_t)k * XSK] = f2bf(hr); xp[(size_t)k * XSK + 64] = f2bf(hi);
                    const float nr = l16.x * hr - l16.y * hi + sr[k], ni = l16.x * hi + l16.y * hr + si[k]; hr = nr; hi = ni;
                }
                __syncthreads();
            }
        }
#endif
#ifndef NO_ATTN
        for (int pid = bid; pid < 256; pid += G) {
            const int bh = (pid & 7) * 8 + (pid >> 5), xq = (pid >> 3) & 3;
            attn_unit(lds, Qb, KN, KPE, VT, Y, ssq_b_, bh >> 3, bh & 7, 7 - xq);
            attn_unit(lds, Qb, KN, KPE, VT, Y, ssq_b_, bh >> 3, bh & 7, xq);
        }
#endif
#ifndef NO_META
        for (int pid = bid; pid < 8; pid += G) attn_meta(lds, Qb, KN, KPE, VT, Y, ssq_b_, 0, pid);
#endif
    xcd_barrier(xbar);
    }

#endif
#if PH_ON(4)
    for (int task = bid * 8 + wid; task < 2048; task += G * 8) {
        const int g = task >> 5, i2 = (task >> 4) & 1, c = task & 15, n = (14 + i2) * 16 + c;
        const float v = wave_sum(dot4(*(const u32x2*)(XS + ((size_t)(g * GRP + 1024)) * XSK + lane * 4), *(const u32x2*)(MIO + ((size_t)(g * 256 + n)) * XSK + lane * 4)));
        if (lane == 0) { const float a = v + p.in[11][g * 16 + c] * bf2f(XS[((size_t)(g * GRP + 1024)) * XSK + n]);
            Gb[(size_t)(16384 + i2) * 1024 + g * 16 + c] = f2bf(a * sigmoidf_(1.5957691216f * (a + 0.044715f * a * a * a))); }
    }
    { GSched<0> S; S.init(XS, MIO, XSK, XSK, 4, 1, 64, (size_t)GRP * XSK * 2, (size_t)256 * XSK * 2); EpiY E{XS, Gb, p.in[11]}; gemm_phase(lds, S, E); }
    xcd_barrier(xbar);

#endif
#if PH_ON(5)
    {
        LAS float* red = (LAS float*)lds;
        for (int c0_ = bid * 4; c0_ < 1024; c0_ += G * 4) {
            float ssl0 = 0.f, ssl1 = 0.f;
            if (wid < 4) {
                const int col = c0_ + wid; float a0 = 0.f, a1 = 0.f;
#pragma unroll
                for (int hk = 0; hk < 2; ++hk) { const int k = lane * 16 + hk * 8;
                    const u32x4 w = *(const u32x4*)(WgluT + (size_t)col * 1024 + k);
                    a0 += dot8(*(const u32x4*)(Gb + (size_t)16384 * 1024 + k), w); a1 += dot8(*(const u32x4*)(Gb + (size_t)16385 * 1024 + k), w); }
                a0 = wave_sum(a0); a1 = wave_sum(a1);
                const float bb = p.in[13][col];
                const float o0 = bf2f(Gb[(size_t)16384 * 1024 + col]) * sigmoidf_(a0 + bb), o1 = bf2f(Gb[(size_t)16385 * 1024 + col]) * sigmoidf_(a1 + bb);
                if (lane == 0) { Y[(size_t)16384 * 2048 + col] = (bf16_t)(cvt_pk(o0, 0.f) & 0xffff); Y[(size_t)16385 * 2048 + col] = (bf16_t)(cvt_pk(o1, 0.f) & 0xffff); }
                ssl0 = o0 * o0; ssl1 = o1 * o1;
            }
            if (lane == 0) { red[wid * 2] = ssl0; red[wid * 2 + 1] = ssl1; }
            __syncthreads();
            if (tid < 2) { float t_ = 0.f; for (int w2 = 0; w2 < 8; ++w2) t_ += red[w2 * 2 + tid]; atomicAdd(ssq_a + 16384 + tid, t_); }
            __syncthreads();
        }
    }
    { GSched<0> S; S.init(Gb, WgluT, 1024, 1024, 64, 4, 1, 0, 0); EpiGlu E{Gb, Y, p.in[13], ssq_a}; gemm_phase(lds, S, E); }
    xcd_barrier(xbar);

#endif
#if PH_ON(6)
    {
        LAS float* red = (LAS float*)lds;
        const float sc0 = (lane < 32) ? rsqrtf(ssq_a[16384] * (1.0f / 1024.0f) + EPS) : rsqrtf(ssq_b[16384] * (1.0f / 1024.0f) + EPS);
        const float sc1 = (lane < 32) ? rsqrtf(ssq_a[16385] * (1.0f / 1024.0f) + EPS) : rsqrtf(ssq_b[16385] * (1.0f / 1024.0f) + EPS);
        for (int c0_ = bid * 8; c0_ < 2048; c0_ += G * 8) {
            const int col = c0_ + wid; float a0 = 0.f, a1 = 0.f;
#pragma unroll
            for (int hk = 0; hk < 4; ++hk) { const int k = lane * 32 + hk * 8;
                const u32x4 w = *(const u32x4*)(WoutT + (size_t)col * 2048 + k);
                a0 += dot8(*(const u32x4*)(Y + (size_t)16384 * 2048 + k), w); a1 += dot8(*(const u32x4*)(Y + (size_t)16385 * 2048 + k), w); }
            a0 *= sc0; a1 *= sc1;
            a0 = wave_sum(a0); a1 = wave_sum(a1);
            const float h0 = meta[(size_t)14 * 2048 + col] + a0, h1v = meta[(size_t)15 * 2048 + col] + a1;
            if (lane < 16) { const int bb = lane >> 1, ii = lane & 1; XH[(size_t)(bb * XHB + ii) * 2048 + col] = (bf16_t)(cvt_pk(ii ? h1v : h0, 0.f) & 0xffff); }
            if (lane == 0) { red[wid * 2] = h0 * h0; red[wid * 2 + 1] = h1v * h1v; }
            __syncthreads();
            if (tid < 16) { const int ii = tid & 1; float t_ = 0.f; for (int w2 = 0; w2 < 8; ++w2) t_ += red[w2 * 2 + ii]; atomicAdd(ssq_h + (tid >> 1) * XHB + ii, t_); }
            __syncthreads();
        }
    }
    { GSched<0> S; S.init(Y, WoutT, 2048, 2048, 64, 8, 1, 0, 0); EpiOut E{ssq_a, ssq_b, XN, rinvx, p.in[2], XH, ssq_h}; gemm_phase(lds, S, E); }
    xcd_barrier(xbar);

#endif
#if PH_ON(7)
#pragma unroll 1
    for (int rep = 0; rep < 1 + DUP_ON(7); ++rep)
    { { GSched<1> S; S.init(XH, WupT, 2048, 2048, 65, 43, 1, 0, 0); EpiUp E{ACT, ssq_h, p.in[23], p.in[24]}; gemm_phase(lds, S, E); }
    xcd_barrier(xbar); }

#endif
#if PH_ON(8)
    if (G == 256) { GSched<2> S; S.init(ACT, WdT, DFF, DFF, 64, 8, 1, 0, 0); EpiDownNorm E{XH, p.out, ssq_o, barw + 3584, p.in[26]}; gemm_phase(lds, S, E); }
    else { GSched<0> S; S.init(ACT, WdT, DFF, DFF, 64, 8, 1, 0, 0); EpiDown E{XH, Y, ssq_o}; gemm_phase(lds, S, E); }
    if (G != 256) xcd_barrier(xbar);

#endif
#if PH_ON(9)
    if (G != 256)
    for (int row = bid * 8 + wid; row < 16384; row += G * 8) {
        float* orow = p.out + (size_t)row * 2048; const bf16_t* hrow = Y + (size_t)row * 2048; const float rs = rsqrtf(ssq_o[row] * (1.0f / 2048.0f) + EPS);
#pragma unroll
        for (int i = 0; i < 4; ++i) { const int c = i * 512 + lane * 8; const u32x4 w = *(const u32x4*)(hrow + c);
            u32x2 lo; lo.x = w.x; lo.y = w.y; u32x2 hi; hi.x = w.z; hi.y = w.w;
            *(f32x4*)(orow + c) = unpack4(lo) * rs * *(const f32x4*)(p.in[26] + c); *(f32x4*)(orow + c + 4) = unpack4(hi) * rs * *(const f32x4*)(p.in[26] + c + 4); }
    }
#endif
}

extern "C" void kernel_launch(void* const* d_in, const int* in_sizes, int n_in, void* d_out, int out_size, void* d_ws, size_t ws_size, hipStream_t stream) {
    static int grid_blocks = 0;
    if (!grid_blocks) {
        int dev = 0, cus = 0, per_cu = 0;
        hipGetDevice(&dev);
        hipDeviceGetAttribute(&cus, hipDeviceAttributeMultiprocessorCount, dev);
        if (hipFuncSetAttribute((const void*)fwd_megakernel, hipFuncAttributeMaxDynamicSharedMemorySize, LDS_BYTES) != hipSuccess) fprintf(stderr, "hipFuncSetAttribute failed\n");
        if (hipOccupancyMaxActiveBlocksPerMultiprocessor(&per_cu, (const void*)fwd_megakernel, NTHR, LDS_BYTES) != hipSuccess || per_cu < 1) { fprintf(stderr, "occupancy query failed\n"); per_cu = 1; }
        if (per_cu > 1) per_cu = 1;
        grid_blocks = cus * per_cu;
    }
    Params p{};
    for (int i = 0; i < 27; ++i) p.in[i] = (const float*)d_in[i];
    p.out = (float*)d_out; p.ws = (unsigned char*)d_ws;
    void* args[] = {&p};
    hipError_t e = hipLaunchCooperativeKernel((const void*)fwd_megakernel, dim3(grid_blocks), dim3(NTHR), args, LDS_BYTES, stream);
    if (e != hipSuccess) fprintf(stderr, "cooperative launch failed: %s (grid %d)\n", hipGetErrorString(e), grid_blocks);
}
```

```cpp
#include <hip/hip_runtime.h>
#include <hip/hip_cooperative_groups.h>
#include <cstdio>
#include <cstdint>
namespace cg = cooperative_groups;

#define LAS __attribute__((address_space(3)))
typedef unsigned short bf16_t;
typedef short bf16x8 __attribute__((ext_vector_type(8)));
typedef float f32x4 __attribute__((ext_vector_type(4)));
typedef float f32x16 __attribute__((ext_vector_type(16)));
typedef unsigned u32x4 __attribute__((ext_vector_type(4)));
typedef unsigned u32x2 __attribute__((ext_vector_type(2)));

constexpr int NB = 8, NMETA = 16, LL = 2064, DM = 2048, ROWS = NB * LL, MPAD = 16640;
constexpr int NG = 64, DFF = 5504;
constexpr int NCH = 129, GRP = 1280, XSK = 384, XHB = 2050;
constexpr float EPS = 1e-6f;
constexpr float QSCALE = 0.07216878364870322f * 1.4426950408889634f;
constexpr int NTHR = 512;

constexpr size_t al(size_t x) { return (x + 255) & ~(size_t)255; }
constexpr size_t O_WIN = 0;
constexpr size_t O_WGLU = O_WIN + al((size_t)2048 * 2048 * 2);
constexpr size_t O_WQ = O_WGLU + al((size_t)1024 * 1024 * 2);
constexpr size_t O_WKV = O_WQ + al((size_t)1536 * 512 * 2);
constexpr size_t O_WOUT = O_WKV + al((size_t)2048 * 256 * 2);
constexpr size_t O_WUP = O_WOUT + al((size_t)2048 * 2048 * 2);
constexpr size_t O_WD = O_WUP + al((size_t)11008 * 2048 * 2);
constexpr size_t O_MST = O_WD + al((size_t)2048 * 5504 * 2);
constexpr size_t O_MIO = O_MST + al((size_t)64 * 256 * 256 * 2);
constexpr size_t O_KD = O_MIO + al((size_t)64 * 256 * 384 * 2);
constexpr size_t O_PWC = O_KD + al((size_t)64 * 16 * 256 * 4);
constexpr size_t O_PW1 = O_PWC + al((size_t)4096 * 16 * 8);
constexpr size_t O_COS = O_PW1 + al((size_t)4096 * 16 * 8);
constexpr size_t O_SIN = O_COS + al((size_t)LL * 32 * 4);
constexpr size_t O_SSQ = O_SIN + al((size_t)LL * 32 * 4);
constexpr size_t O_BAR = O_SSQ + al((size_t)7 * MPAD * 4);
constexpr size_t O_Y = O_BAR + al((size_t)4096 * 4);
constexpr size_t O_E = O_Y + al((size_t)MPAD * 2048 * 2);
constexpr size_t O_XN = O_E;
constexpr size_t O_XS = O_XN + al((size_t)MPAD * 2048 * 2);
constexpr size_t O_QA = O_XS + al((size_t)64 * GRP * XSK * 2);
constexpr size_t O_KVA = O_QA + al((size_t)MPAD * 512 * 2);
constexpr size_t O_KPE = O_KVA + al((size_t)MPAD * 256 * 2);
constexpr size_t O_Q = O_KPE + al((size_t)MPAD * 64 * 2);
constexpr size_t O_KN = O_Q + al((size_t)MPAD * 1536 * 2);
constexpr size_t O_VT = O_KN + al((size_t)MPAD * 1024 * 2);
constexpr size_t O_S = O_VT + al((size_t)(NB + 1) * 8 * 128 * 2048 * 2 + 4096);
constexpr size_t O_END1 = O_S + al((size_t)64 * GRP * 128 * 4);
constexpr size_t O_G = O_Q;
constexpr size_t O_ACT = O_E + al((size_t)(NB * XHB + 16) * 2048 * 2);
constexpr size_t O_XH = O_ACT + al((size_t)16384 * DFF * 2);
constexpr size_t O_END2 = O_XH + al((size_t)(NB * XHB + 16) * 2048 * 2);
static_assert(O_XH >= O_KN, "XH must not overlap G (= Q region), read in P5");
static_assert(O_END1 <= (size_t)536870912 && O_END2 <= (size_t)536870912, "workspace map exceeds 512 MiB");

#ifndef PH_MASK
#define PH_MASK 0x3ff
#endif
#define PH_ON(n) ((PH_MASK >> (n)) & 1)
#ifndef DUP_MASK
#define DUP_MASK 0
#endif
#define DUP_ON(n) ((DUP_MASK >> (n)) & 1)
struct Params { const float* in[27]; float* out; unsigned char* ws; };

__device__ __forceinline__ unsigned cvt_pk(float lo, float hi) { unsigned r; asm volatile("v_cvt_pk_bf16_f32 %0, %1, %2" : "=v"(r) : "v"(lo), "v"(hi)); return r; }
__device__ __forceinline__ u32x2 pack4(f32x4 v) { u32x2 r; r.x = cvt_pk(v[0], v[1]); r.y = cvt_pk(v[2], v[3]); return r; }
__device__ __forceinline__ float bf2f(unsigned short b) { return __builtin_bit_cast(float, (unsigned)b << 16); }
__device__ __forceinline__ f32x4 unpack4(u32x2 w) { f32x4 r; r[0] = __builtin_bit_cast(float, w.x << 16); r[1] = __builtin_bit_cast(float, w.x & 0xffff0000u); r[2] = __builtin_bit_cast(float, w.y << 16); r[3] = __builtin_bit_cast(float, w.y & 0xffff0000u); return r; }
__device__ __forceinline__ float wave_sum(float v) {
#pragma unroll
    for (int o = 1; o < 64; o <<= 1) v += __shfl_xor(v, o);
    return v;
}
__device__ __forceinline__ float dpp_shr1(float v) { return __builtin_bit_cast(float, __builtin_amdgcn_update_dpp(0, __builtin_bit_cast(int, v), 0x111, 0xf, 0xf, true)); }
__device__ __forceinline__ float dpp_shr2(float v) { return __builtin_bit_cast(float, __builtin_amdgcn_update_dpp(0, __builtin_bit_cast(int, v), 0x112, 0xf, 0xf, true)); }
__device__ __forceinline__ float dot4(u32x2 a, u32x2 k) {
    return __builtin_bit_cast(float, a.x << 16) * __builtin_bit_cast(float, k.x << 16) + __builtin_bit_cast(float, a.x & 0xffff0000u) * __builtin_bit_cast(float, k.x & 0xffff0000u)
         + __builtin_bit_cast(float, a.y << 16) * __builtin_bit_cast(float, k.y << 16) + __builtin_bit_cast(float, a.y & 0xffff0000u) * __builtin_bit_cast(float, k.y & 0xffff0000u);
}
__device__ __forceinline__ bf16_t f2bf(float v) { return (bf16_t)(cvt_pk(v, 0.f) & 0xffff); }
__device__ __forceinline__ float fexp2(float x) { return __builtin_amdgcn_exp2f(x); }
__device__ __forceinline__ float sigmoidf_(float x) { return __builtin_amdgcn_rcpf(1.0f + __builtin_amdgcn_exp2f(-1.4426950408889634f * x)); }

constexpr int BM = 256, BK = 64, HALF = 128, HTB = HALF * BK * 2, STAGE_BYTES = 8 * HTB;
constexpr int EPF_OFF = STAGE_BYTES + 16384 + 64, EPF_WAVE = 1536;
constexpr int LDS_BYTES = EPF_OFF + 8 * EPF_WAVE;
static_assert(LDS_BYTES <= 163840, "LDS");

__device__ __forceinline__ int lds_byte(int r, int c) { const int st = (r >> 4) * 2 + (c >> 5), rr = r & 15, cc = c & 31, ob = rr * 64 + cc * 2; return st * 1024 + (ob ^ (((ob >> 9) & 1) << 5)); }
__device__ __forceinline__ void stage_rc(int b, int& R, int& C) { const int st = b / 1024, sb = b % 1024, swz = sb ^ (((sb >> 9) & 1) << 5); R = (st >> 1) * 16 + swz / 64; C = (st & 1) * 32 + (swz % 64) / 2; }

struct Unit { int pm, pn, bt; };

template <int MODE>
struct GSched {
    const char* A; const char* Bt; int lda, K; size_t strideA, strideB; int nM, nN, nB, G, c; long nwg;
    __device__ __forceinline__ void init(const void* A_, const void* Bt_, int lda_, int K_, int nM_, int nN_, int nB_, size_t sA, size_t sB) {
        A = (const char*)A_; Bt = (const char*)Bt_; lda = lda_; K = K_; nM = nM_; nN = nN_; nB = nB_; strideA = sA; strideB = sB; G = gridDim.x; c = blockIdx.x; nwg = (long)nM * nN * nB;
    }
    __device__ __forceinline__ bool next(int i, Unit& u) const {
        if (MODE == 2) { if (i >= 2) return false; const int x = c & 7, y = c >> 3; u.pm = 32 * i + 4 * x + (y >> 3); u.pn = y & 7; u.bt = 0; return true; }
        const long L = (long)i * G + c; if (L >= nwg) return false;
        const int per = nM * nN; const int bt = (int)(L / per); int w = (int)(L - (long)bt * per);
        if (nB == 1) { const int q = per / 8, r = per % 8, xcd = w % 8, off = w / 8; w = (xcd < r ? xcd * (q + 1) : r * (q + 1) + (xcd - r) * q) + off; }
        const int nig = 8 * nN, gid = w / nig, fm = gid * 8, gsz = (nM - fm) < 8 ? (nM - fm) : 8;
        u.pm = fm + ((w % nig) % gsz); u.pn = (w % nig) / gsz; u.bt = bt; return true;
    }
    __device__ __forceinline__ const char* a_base(const Unit& u) const {
        if (MODE == 1) { if (u.pm == 64) return A; return A + (size_t)((u.pm >> 3) * XHB + (u.pm & 7) * 256) * lda * 2; }
        return A + (size_t)u.bt * strideA + (size_t)u.pm * 256 * lda * 2;
    }
    __device__ __forceinline__ size_t a_hstep(const Unit& u) const { if (MODE == 1 && u.pm == 64) return (size_t)4 * XHB * lda * 2; return (size_t)HALF * lda * 2; }
    __device__ __forceinline__ unsigned a_voff(const Unit& u, int R, int C) const {
        if (MODE == 1 && u.pm == 64) return (unsigned)(((R >> 5) * XHB + ((R >> 2) & 7) * 256 + 254 + (R & 3)) * lda + C) * 2u;
        return (unsigned)(R * lda + C) * 2u;
    }
    __device__ __forceinline__ const char* b_base(const Unit& u) const { return Bt + (size_t)u.bt * strideB + (size_t)u.pn * 256 * K * 2; }
};

template <class Epi, class Sched>
__device__ __forceinline__ void gemm_phase(LAS unsigned char* lds, const Sched& S, const Epi& E) {
    int tid = threadIdx.x; asm volatile("" : "+v"(tid));
    const int wid = __builtin_amdgcn_readfirstlane(tid >> 6), lane = tid & 63, wr = wid >> 2, wc = wid & 3, fr = lane & 15, fq = lane >> 4;
    const int K = S.K, nt = K / BK;
    int sR[2], sC[2]; unsigned voffB[2];
#pragma unroll
    for (int i = 0; i < 2; ++i) { stage_rc(tid * 16 + i * 8192, sR[i], sC[i]); voffB[i] = (unsigned)(sR[i] * K + sC[i]) * 2u; }
    const size_t kstep = (size_t)(BK * 2), hstepB = (size_t)HALF * K * 2;
    const unsigned ldsw = (unsigned)wid * 1024u;
    const int aoff = lds_byte(wr * 64 + fr, fq * 8), boff = lds_byte(wc * 32 + fr, fq * 8);
#define G_SA(b, h) (((b) * 2 + (h)) * HTB)
#define G_SB(b, h) ((4 + (b) * 2 + (h)) * HTB)
#define G_STAGE(bufoff, gbase, v0, v1) do { \
        __builtin_amdgcn_global_load_lds((const unsigned*)((const char*)(gbase) + (v0)), (LAS unsigned*)(lds + (bufoff) + ldsw), 16, 0, 0); \
        __builtin_amdgcn_global_load_lds((const unsigned*)((const char*)(gbase) + (v1)), (LAS unsigned*)(lds + (bufoff) + ldsw + 8192), 16, 0, 0); } while (0)
#define G_LDA(dst, b, h) do { _Pragma("unroll") for (int m = 0; m < 4; ++m) _Pragma("unroll") for (int k = 0; k < 2; ++k) dst[m][k] = *(const LAS bf16x8*)(lds + G_SA(b, h) + aoff + m * 2048 + k * 1024); } while (0)
#define G_LDB(dst, b, h) do { _Pragma("unroll") for (int n = 0; n < 2; ++n) _Pragma("unroll") for (int k = 0; k < 2; ++k) dst[n][k] = *(const LAS bf16x8*)(lds + G_SB(b, h) + boff + n * 2048 + k * 1024); } while (0)
#define G_MMA(ai, bj, At, Bt) do { __builtin_amdgcn_s_setprio(1); _Pragma("unroll") for (int m = 0; m < 4; ++m) _Pragma("unroll") for (int n = 0; n < 2; ++n) _Pragma("unroll") for (int k = 0; k < 2; ++k) \
        acc[ai][bj][m][n] = __builtin_amdgcn_mfma_f32_16x16x32_bf16(Bt[n][k], At[m][k], acc[ai][bj][m][n], 0, 0, 0); __builtin_amdgcn_s_setprio(0); } while (0)
#define G_WAIT_V(n) asm volatile("s_waitcnt vmcnt(" #n ")" ::: "memory")
#define G_WAIT_L(n) asm volatile("s_waitcnt lgkmcnt(" #n ")" ::: "memory")
#define G_BAR __builtin_amdgcn_s_barrier()
#define G_SCHED __builtin_amdgcn_sched_barrier(0)
    Unit cur, nxt; int ui = 0;
    if (!S.next(0, cur)) return;
    f32x4 acc[2][2][4][2];
#pragma unroll
    for (int a = 0; a < 2; ++a)
#pragma unroll
        for (int b = 0; b < 2; ++b)
#pragma unroll
            for (int m = 0; m < 4; ++m)
#pragma unroll
                for (int n = 0; n < 2; ++n) acc[a][b][m][n] = (f32x4){0.f, 0.f, 0.f, 0.f};
    bf16x8 At[4][2], B0[2][2], B1[2][2];
    const char* cA = S.a_base(cur); const char* cB = S.b_base(cur);
    unsigned vc0 = S.a_voff(cur, sR[0], sC[0]), vc1 = S.a_voff(cur, sR[1], sC[1]); size_t hAc = S.a_hstep(cur);
    const unsigned vb0 = voffB[0], vb1 = voffB[1];
    if constexpr (Epi::PREFETCH) E.prefetch(cur, wr, wc, lane, lds + EPF_OFF + wid * EPF_WAVE);
    G_STAGE(G_SB(0, 0), cB, vb0, vb1); G_STAGE(G_SB(0, 1), cB + hstepB, vb0, vb1); G_STAGE(G_SA(0, 0), cA, vc0, vc1); G_STAGE(G_SA(0, 1), cA + hAc, vc0, vc1);
    if (wr == 1) G_BAR;
    G_WAIT_V(2); G_BAR;
    G_STAGE(G_SB(1, 0), cB + kstep, vb0, vb1); G_STAGE(G_SA(1, 0), cA + kstep, vc0, vc1); G_STAGE(G_SB(1, 1), cB + hstepB + kstep, vb0, vb1);
    G_WAIT_V(6); G_BAR;
    for (;;) {
        const bool has_next = S.next(ui + 1, nxt);
        const char* nA = has_next ? S.a_base(nxt) : cA; const char* nB = has_next ? S.b_base(nxt) : cB;
        const unsigned vn0 = has_next ? S.a_voff(nxt, sR[0], sC[0]) : vc0, vn1 = has_next ? S.a_voff(nxt, sR[1], sC[1]) : vc1; const size_t hAn = has_next ? S.a_hstep(nxt) : hAc;
        for (int t = 0; t < nt; t += 2) {
            const bool last = (t == nt - 2);
            if constexpr (Epi::MIDSCALE) { if (t == nt / 2) { int e_fr = fr, e_wr = wr; asm volatile("" : "+v"(e_fr)); asm volatile("" : "+s"(e_wr)); E.mid(acc, cur, e_wr, e_fr); } }
            const char* a1 = cA + (size_t)(t + 1) * kstep;
            const char* a2 = last ? nA : cA + (size_t)(t + 2) * kstep; const char* b2 = last ? nB : cB + (size_t)(t + 2) * kstep;
            const char* a3 = a2 + kstep; const char* b3 = b2 + kstep;
            const unsigned v20 = last ? vn0 : vc0, v21 = last ? vn1 : vc1; const size_t h2 = last ? hAn : hAc;
            G_LDB(B0, 0, 0); G_LDB(B1, 0, 1); G_SCHED; G_LDA(At, 0, 0); G_STAGE(G_SA(1, 1), a1 + hAc, vc0, vc1);
            G_WAIT_V(8); G_WAIT_L(0); G_BAR; G_MMA(0, 0, At, B0); G_MMA(0, 1, At, B1); G_BAR; G_SCHED;
            G_LDA(At, 0, 1); G_STAGE(G_SB(0, 0), b2, vb0, vb1); G_STAGE(G_SB(0, 1), b2 + hstepB, vb0, vb1); G_STAGE(G_SA(0, 0), a2, v20, v21);
            G_WAIT_V(8); G_WAIT_L(0); G_BAR; G_MMA(1, 0, At, B0); G_MMA(1, 1, At, B1); G_BAR; G_SCHED;
            G_LDB(B0, 1, 0); G_LDB(B1, 1, 1); G_SCHED; G_LDA(At, 1, 0); G_STAGE(G_SA(0, 1), a2 + h2, v20, v21);
            G_WAIT_V(8); G_WAIT_L(0); G_BAR; G_MMA(0, 0, At, B0); G_MMA(0, 1, At, B1); G_BAR; G_SCHED;
            G_LDA(At, 1, 1); G_STAGE(G_SB(1, 0), b3, vb0, vb1); G_STAGE(G_SB(1, 1), b3 + hstepB, vb0, vb1); G_STAGE(G_SA(1, 0), a3, v20, v21);
            G_WAIT_V(8); G_WAIT_L(0); G_BAR; G_MMA(1, 0, At, B0); G_MMA(1, 1, At, B1); G_BAR; G_SCHED;
        }
        if (wr == 0) G_BAR;
        { int e_fr = fr, e_fq = fq, e_wr = wr, e_wc = wc; asm volatile("" : "+v"(e_fr), "+v"(e_fq)); asm volatile("" : "+s"(e_wr), "+s"(e_wc));
          E(acc, cur, e_wr, e_wc, e_fr, e_fq, lds + STAGE_BYTES);
          if constexpr (Epi::PREFETCH) { if (has_next) { int e_lane = lane; asm volatile("" : "+v"(e_lane)); E.prefetch(nxt, e_wr, e_wc, e_lane, lds + EPF_OFF + wid * EPF_WAVE); } } }
        if (!has_next) break;
#pragma unroll
        for (int a = 0; a < 2; ++a)
#pragma unroll
            for (int b = 0; b < 2; ++b)
#pragma unroll
                for (int m = 0; m < 4; ++m)
#pragma unroll
                    for (int n = 0; n < 2; ++n) acc[a][b][m][n] = (f32x4){0.f, 0.f, 0.f, 0.f};
        cur = nxt; cA = nA; cB = nB; vc0 = vn0; vc1 = vn1; hAc = hAn; ++ui;
        if (wr == 1) G_BAR;
    }
    G_WAIT_V(0);
    G_BAR;
}

#define EPI_ARGS f32x4 (&acc)[2][2][4][2], const Unit& u, int wr, int wc, int fr, int fq, LAS unsigned char* xl
#define FOR_AI_M _Pragma("unroll") for (int ai = 0; ai < 2; ++ai) _Pragma("unroll") for (int m = 0; m < 4; ++m)
#define FOR_BJ_N _Pragma("unroll") for (int bj = 0; bj < 2; ++bj) _Pragma("unroll") for (int n = 0; n < 2; ++n)

struct EpiZ {
    static constexpr bool MIDSCALE = false, PREFETCH = false;
    bf16_t* XS; bf16_t* QA; bf16_t* KVA; bf16_t* KPE; float* ssq_q; float* ssq_kv; const float* cs; const float* sn;
    __device__ __forceinline__ void operator()(EPI_ARGS) const {
        const int pn = u.pn;
        FOR_AI_M {
            const int row = u.pm * 256 + ai * 128 + wr * 64 + m * 16 + fr;
            if (pn < 4) {
                FOR_BJ_N { const int g = 16 * pn + 8 * bj + 2 * wc + n;
                    *(u32x2*)(XS + ((size_t)(g * GRP + (row >> 4)) * XSK + (row & 15) * 16 + 4 * fq)) = pack4(acc[ai][bj][m][n]); }
            } else if (pn < 7) {
                float ss = 0.f;
                FOR_BJ_N { const f32x4 v = acc[ai][bj][m][n]; ss += v[0] * v[0] + v[1] * v[1] + v[2] * v[2] + v[3] * v[3];
                    const int col = bj * 128 + wc * 32 + n * 16 + 4 * fq;
                    if (pn < 6) *(u32x2*)(QA + ((size_t)row * 512 + (pn - 4) * 256 + col)) = pack4(v);
                    else *(u32x2*)(KVA + ((size_t)row * 256 + col)) = pack4(v); }
                ss += __shfl_xor(ss, 16); ss += __shfl_xor(ss, 32);
                if (fq == 0 && ssq_q) atomicAdd((pn < 6 ? ssq_q : ssq_kv) + row, ss);
            } else {
                if (wc < 2) {
                    const int t = (row & 2047) + 16; const f32x4 x1 = acc[ai][0][m][0], x2 = acc[ai][0][m][1]; f32x4 y1, y2;
                    const f32x4 c = *(const f32x4*)(cs + t * 32 + wc * 16 + 4 * fq), s = *(const f32x4*)(sn + t * 32 + wc * 16 + 4 * fq);
#pragma unroll
                    for (int e = 0; e < 4; ++e) { y1[e] = x1[e] * c[e] - x2[e] * s[e]; y2[e] = x2[e] * c[e] + x1[e] * s[e]; }
                    *(u32x2*)(KPE + ((size_t)row * 64 + wc * 32 + 4 * fq)) = pack4(y1);
                    *(u32x2*)(KPE + ((size_t)row * 64 + wc * 32 + 16 + 4 * fq)) = pack4(y2);
                }
            }
        }
    }
};

struct EpiQ {
    static constexpr bool MIDSCALE = false, PREFETCH = false;
    bf16_t* Q; const float* ssq_q; const float* cs; const float* sn;
    __device__ __forceinline__ void operator()(EPI_ARGS) const {
        FOR_AI_M {
            const int row = u.pm * 256 + ai * 128 + wr * 64 + m * 16 + fr;
            const float rs = rsqrtf(ssq_q[row] * (1.0f / 512.0f) + EPS) * QSCALE;
            const int t = (row & 2047) + 16;
#pragma unroll
            for (int bj = 0; bj < 2; ++bj) {
                const int cb = u.pn * 256 + bj * 128 + wc * 32;
                f32x4 v0 = acc[ai][bj][m][0] * rs, v1 = acc[ai][bj][m][1] * rs;
                if (((cb >> 6) % 3) == 2) {
                    const int j = (wc & 1) * 16 + 4 * fq;
                    const f32x4 c = *(const f32x4*)(cs + t * 32 + j), s = *(const f32x4*)(sn + t * 32 + j); f32x4 y1, y2;
#pragma unroll
                    for (int e = 0; e < 4; ++e) { y1[e] = v0[e] * c[e] - v1[e] * s[e]; y2[e] = v1[e] * c[e] + v0[e] * s[e]; }
                    v0 = y1; v1 = y2;
                }
                *(u32x2*)(Q + ((size_t)row * 1536 + cb + 4 * fq)) = pack4(v0);
                *(u32x2*)(Q + ((size_t)row * 1536 + cb + 16 + 4 * fq)) = pack4(v1);
            }
        }
    }
};

struct EpiKV {
    static constexpr bool MIDSCALE = false, PREFETCH = false;
    bf16_t* KN; bf16_t* VT; const float* ssq_kv;
    __device__ __forceinline__ void operator()(EPI_ARGS) const {
        FOR_AI_M {
            const int row = u.pm * 256 + ai * 128 + wr * 64 + m * 16 + fr;
            {
                const float rs = rsqrtf(ssq_kv[row] * (1.0f / 256.0f) + EPS);
                const int b = row >> 11, t = row & 2047;
#pragma unroll
                for (int n = 0; n < 2; ++n) {
                    *(u32x2*)(KN + ((size_t)row * 1024 + u.pn * 128 + wc * 32 + n * 16 + 4 * fq)) = pack4(acc[ai][0][m][n] * rs);
                    const f32x4 v = acc[ai][1][m][n] * rs; const int d = wc * 32 + n * 16 + 4 * fq;
                    bf16_t* vp = VT + ((size_t)((b * 8 + u.pn) * 128 + d)) * 2048 + t;
                    const unsigned w0 = cvt_pk(v[0], v[1]), w1 = cvt_pk(v[2], v[3]);
                    vp[0] = (bf16_t)(w0 & 0xffff); vp[2048] = (bf16_t)(w0 >> 16); vp[2 * 2048] = (bf16_t)(w1 & 0xffff); vp[3 * 2048] = (bf16_t)(w1 >> 16);
                }
            }
        }
    }
};

struct EpiS {
    static constexpr bool MIDSCALE = false, PREFETCH = false;
    float* S;
    __device__ __forceinline__ void operator()(EPI_ARGS) const {
        FOR_AI_M {
            const int R = u.pm * 256 + ai * 128 + wr * 64 + m * 16 + fr;
#pragma unroll
            for (int n = 0; n < 2; ++n) *(f32x4*)(S + ((size_t)(u.bt * GRP + R) * 128 + wc * 32 + n * 16 + 4 * fq)) = acc[ai][0][m][n];
        }
    }
};

struct EpiY {
    static constexpr bool MIDSCALE = false, PREFETCH = false;
    const bf16_t* XS; bf16_t* G; const float* dskip;
    __device__ __forceinline__ void operator()(EPI_ARGS) const {
        const int g = u.bt;
        const f32x4 dk = *(const f32x4*)(dskip + g * 16 + 4 * fq);
        FOR_AI_M {
            const int R = u.pm * 256 + ai * 128 + wr * 64 + m * 16 + fr;
            {
                FOR_BJ_N { const int col = bj * 128 + wc * 32 + n * 16 + 4 * fq; const int t = col >> 4;
                    const int grow = R * 16 + t;
                    const f32x4 uu = unpack4(*(const u32x2*)(XS + ((size_t)(g * GRP + R) * XSK + col)));
                    f32x4 y = acc[ai][bj][m][n] + dk * uu, o;
#pragma unroll
                    for (int e = 0; e < 4; ++e) { const float a = y[e]; o[e] = a * sigmoidf_(1.5957691216f * (a + 0.044715f * a * a * a)); }
                    *(u32x2*)(G + ((size_t)grow * 1024 + g * 16 + 4 * fq)) = pack4(o); }
            }
        }
    }
};

struct EpiGlu {
    static constexpr bool MIDSCALE = false, PREFETCH = false;
    const bf16_t* G; bf16_t* Y; const float* bglu; float* ssq_a;
    __device__ __forceinline__ void operator()(EPI_ARGS) const {
        FOR_AI_M {
            const int row = u.pm * 256 + ai * 128 + wr * 64 + m * 16 + fr; float ss = 0.f;
            FOR_BJ_N { const int col = u.pn * 256 + bj * 128 + wc * 32 + n * 16 + 4 * fq;
                const f32x4 gg = unpack4(*(const u32x2*)(G + ((size_t)row * 1024 + col))); const f32x4 bb = *(const f32x4*)(bglu + col); f32x4 o;
#pragma unroll
                for (int e = 0; e < 4; ++e) { o[e] = gg[e] * sigmoidf_(acc[ai][bj][m][n][e] + bb[e]); ss += o[e] * o[e]; }
                *(u32x2*)(Y + ((size_t)row * 2048 + col)) = pack4(o); }
            ss += __shfl_xor(ss, 16); ss += __shfl_xor(ss, 32);
            if (fq == 0) atomicAdd(ssq_a + row, ss);
        }
    }
};

struct EpiOut {
    static constexpr bool MIDSCALE = true, PREFETCH = false;
    const float* ssq_a; const float* ssq_b; const bf16_t* XN; const float* rinvx; const float* gmix; bf16_t* XH; float* ssq_h;
    __device__ __forceinline__ void mid(f32x4 (&acc)[2][2][4][2], const Unit& u, int wr, int fr) const {
        FOR_AI_M {
            const int row = u.pm * 256 + ai * 128 + wr * 64 + m * 16 + fr;
            const float ra = rsqrtf(ssq_a[row] * (1.0f / 1024.0f) + EPS), rb = rsqrtf(ssq_b[row] * (1.0f / 1024.0f) + EPS); const float r = ra / rb;
            FOR_BJ_N acc[ai][bj][m][n] *= r;
        }
    }
    __device__ __forceinline__ void operator()(EPI_ARGS) const {
        f32x4 ginv[2][2];
        FOR_BJ_N { const f32x4 gg = *(const f32x4*)(gmix + u.pn * 256 + bj * 128 + wc * 32 + n * 16 + 4 * fq);
#pragma unroll
            for (int e = 0; e < 4; ++e) ginv[bj][n][e] = __builtin_amdgcn_rcpf(gg[e]); }
        FOR_AI_M {
            const int row = u.pm * 256 + ai * 128 + wr * 64 + m * 16 + fr;
            const float rb = rsqrtf(ssq_b[row] * (1.0f / 1024.0f) + EPS), ri = rinvx[row];
            const int b = row >> 11, tp = row & 2047;
            const bf16_t* hrow = XN + (size_t)row * 2048;
            float ss = 0.f;
            FOR_BJ_N { const int col = u.pn * 256 + bj * 128 + wc * 32 + n * 16 + 4 * fq;
                const f32x4 v = acc[ai][bj][m][n] * rb + unpack4(*(const u32x2*)(hrow + col)) * (ginv[bj][n] * ri);
                ss += v[0] * v[0] + v[1] * v[1] + v[2] * v[2] + v[3] * v[3];
                *(u32x2*)(XH + ((size_t)(b * XHB + tp + 2) * 2048 + col)) = pack4(v); }
            ss += __shfl_xor(ss, 16); ss += __shfl_xor(ss, 32);
            if (fq == 0) atomicAdd(ssq_h + b * XHB + tp + 2, ss);
        }
    }
};

struct EpiUp {
    static constexpr bool MIDSCALE = false, PREFETCH = true;
    bf16_t* ACT; const float* ssq_h; const float* cw; const float* cb;
    __device__ __forceinline__ void prefetch(const Unit& u, int wr, int wc, int lane, LAS unsigned char* pf) const {
        const bool gather = (u.pm == 64);
#pragma unroll
        for (int ai = 0; ai < 2; ++ai) {
            const int R = ai * 128 + wr * 64 + lane;
            const int xrow = gather ? ((R >> 5) * XHB + ((R >> 2) & 7) * 256 + 254 + (R & 3)) : ((u.pm >> 3) * XHB + (u.pm & 7) * 256 + R);
            __builtin_amdgcn_global_load_lds((const unsigned*)(ssq_h + xrow), (LAS unsigned*)(pf + ai * 256), 4, 0, 0);
        }
        const int l5 = lane & 31, a = l5 >> 3, piece = l5 & 7;
        const float* src = (a < 3 ? cw + a * DFF : cb) + u.pn * 128 + wc * 32 + piece * 4;
        __builtin_amdgcn_global_load_lds((const unsigned*)src, (LAS unsigned*)(pf + 512), 16, 0, 0);
    }
    __device__ __forceinline__ void operator()(EPI_ARGS) const {
        LAS float* halo = (LAS float*)xl;
        const bool gather = (u.pm == 64);
        const LAS float* pf = (const LAS float*)(xl + (EPF_OFF - STAGE_BYTES) + (wr * 4 + wc) * EPF_WAVE);
        float rsv[2][4];
        FOR_AI_M { rsv[ai][m] = pf[ai * 64 + m * 16 + fr]; }
        f32x4 W0[2], W1[2], W2[2], BB[2];
#pragma unroll
        for (int n = 0; n < 2; ++n) { const int c8 = 8 * fq + 4 * n;
            W0[n] = *(const LAS f32x4*)(pf + 128 + c8); W1[n] = *(const LAS f32x4*)(pf + 128 + 32 + c8); W2[n] = *(const LAS f32x4*)(pf + 128 + 64 + c8); BB[n] = *(const LAS f32x4*)(pf + 128 + 96 + c8); }
        FOR_AI_M {
            const float rs = rsqrtf(rsv[ai][m] * (1.0f / 2048.0f) + EPS);
            FOR_BJ_N acc[ai][bj][m][n] *= rs;
            if (fr >= 14) {
                const int rb = ai * 8 + wr * 4 + m;
#pragma unroll
                for (int n = 0; n < 2; ++n) *(LAS f32x4*)(halo + ((rb * 2 + (fr - 14)) * 128 + wc * 32 + 8 * fq + 4 * n)) = acc[ai][0][m][n];
            }
        }
        asm volatile("s_waitcnt lgkmcnt(0)" ::: "memory"); __builtin_amdgcn_s_barrier(); asm volatile("" ::: "memory");
        FOR_AI_M {
            const int R = ai * 128 + wr * 64 + m * 16 + fr; const int rb = ai * 8 + wr * 4 + m;
            u32x4 ow;
            const bool valid = gather ? ((R & 3) >= 2) : (R >= 2);
            const int orow = gather ? (256 * (R >> 2) + 252 + (R & 3)) : (256 * u.pm + R - 2);
#pragma unroll
            for (int n = 0; n < 2; ++n) {
                const int cl = wc * 32 + 8 * fq + 4 * n;
                f32x4 hA = (f32x4){0.f, 0.f, 0.f, 0.f}, hB = (f32x4){0.f, 0.f, 0.f, 0.f};
                if (fr < 2 && rb > 0) { hA = *(const LAS f32x4*)(halo + (((rb - 1) * 2 + fr) * 128 + cl)); if (fr == 0) hB = *(const LAS f32x4*)(halo + (((rb - 1) * 2 + 1) * 128 + cl)); }
                const f32x4 g0 = acc[ai][0][m][n], vv = acc[ai][1][m][n];
                f32x4 d1, d2;
#pragma unroll
                for (int e = 0; e < 4; ++e) { d1[e] = dpp_shr1(g0[e]); d2[e] = dpp_shr2(g0[e]); }
                const f32x4 g1 = d1 + hB, g2 = d2 + hA;
                const f32x4 cv = W0[n] * g2 + (W1[n] * g1 + (W2[n] * g0 + BB[n]));
                const f32x4 tt = cv * -1.4426950408889634f; f32x4 den;
#pragma unroll
                for (int e = 0; e < 4; ++e) den[e] = __builtin_amdgcn_exp2f(tt[e]);
                den = den + 1.0f; f32x4 rc;
#pragma unroll
                for (int e = 0; e < 4; ++e) rc[e] = __builtin_amdgcn_rcpf(den[e]);
                const f32x4 o = (cv * rc) * vv;
                const u32x2 pk = pack4(o); if (n == 0) { ow.x = pk.x; ow.y = pk.y; } else { ow.z = pk.x; ow.w = pk.y; }
            }
            if (valid) *(u32x4*)(ACT + ((size_t)orow * DFF + u.pn * 128 + wc * 32 + 8 * fq)) = ow;
        }
    }
};

struct EpiDown {
    static constexpr bool MIDSCALE = false, PREFETCH = false;
    const bf16_t* XH; bf16_t* H2; float* ssq_o;
    __device__ __forceinline__ void operator()(EPI_ARGS) const {
        FOR_AI_M {
            const int row = u.pm * 256 + ai * 128 + wr * 64 + m * 16 + fr; float ss = 0.f;
            const bf16_t* hrow = XH + (size_t)((row >> 11) * XHB + (row & 2047) + 2) * 2048;
            FOR_BJ_N { const int col = u.pn * 256 + bj * 128 + wc * 32 + n * 16 + 4 * fq;
                const f32x4 v = unpack4(*(const u32x2*)(hrow + col)) + acc[ai][bj][m][n];
                ss += v[0] * v[0] + v[1] * v[1] + v[2] * v[2] + v[3] * v[3]; *(u32x2*)(H2 + ((size_t)row * 2048 + col)) = pack4(v); }
            ss += __shfl_xor(ss, 16); ss += __shfl_xor(ss, 32);
            if (fq == 0) atomicAdd(ssq_o + row, ss);
        }
    }
};

struct EpiDownNorm {
    static constexpr bool MIDSCALE = false, PREFETCH = false;
    const bf16_t* XH; float* out; float* ssq_o; unsigned* cnt; const float* gain;
    __device__ __forceinline__ void operator()(EPI_ARGS) const {
        FOR_AI_M {
            const int row = u.pm * 256 + ai * 128 + wr * 64 + m * 16 + fr; float ss = 0.f;
            const bf16_t* hrow = XH + (size_t)((row >> 11) * XHB + (row & 2047) + 2) * 2048;
            FOR_BJ_N { const int col = u.pn * 256 + bj * 128 + wc * 32 + n * 16 + 4 * fq;
                const f32x4 v = unpack4(*(const u32x2*)(hrow + col)) + acc[ai][bj][m][n]; acc[ai][bj][m][n] = v;
                ss += v[0] * v[0] + v[1] * v[1] + v[2] * v[2] + v[3] * v[3]; }
            ss += __shfl_xor(ss, 16); ss += __shfl_xor(ss, 32);
            if (fq == 0) __hip_atomic_fetch_add(ssq_o + row, ss, __ATOMIC_RELAXED, __HIP_MEMORY_SCOPE_AGENT);
        }
        asm volatile("s_waitcnt vmcnt(0)" ::: "memory"); __builtin_amdgcn_s_barrier(); asm volatile("" ::: "memory");
        if (threadIdx.x == 0) {
            __builtin_amdgcn_fence(__ATOMIC_RELEASE, "agent");
            __hip_atomic_fetch_add(cnt + u.pm, 1u, __ATOMIC_RELAXED, __HIP_MEMORY_SCOPE_AGENT);
            unsigned sp = 0;
            while (__hip_atomic_load(cnt + u.pm, __ATOMIC_RELAXED, __HIP_MEMORY_SCOPE_AGENT) < 8u) { __builtin_amdgcn_s_sleep(1); if (++sp > (1u << 22)) break; }
            __builtin_amdgcn_fence(__ATOMIC_ACQUIRE, "agent");
            asm volatile("s_waitcnt vmcnt(0)" ::: "memory");
        }
        __builtin_amdgcn_s_barrier(); asm volatile("" ::: "memory");
        f32x4 gv[2][2];
#pragma unroll
        for (int bj = 0; bj < 2; ++bj)
#pragma unroll
            for (int n = 0; n < 2; ++n) gv[bj][n] = *(const f32x4*)(gain + u.pn * 256 + bj * 128 + wc * 32 + n * 16 + 4 * fq);
        FOR_AI_M {
            const int row = u.pm * 256 + ai * 128 + wr * 64 + m * 16 + fr;
            const float rs = rsqrtf(__hip_atomic_load(ssq_o + row, __ATOMIC_RELAXED, __HIP_MEMORY_SCOPE_AGENT) * (1.0f / 2048.0f) + EPS);
            FOR_BJ_N { const int col = u.pn * 256 + bj * 128 + wc * 32 + n * 16 + 4 * fq;
                __builtin_nontemporal_store(acc[ai][bj][m][n] * rs * gv[bj][n], (f32x4*)(out + ((size_t)row * 2048 + col))); }
        }
    }
};

__device__ __forceinline__ int sigma64(int p) { return (p >> 5) * 16 + (p & 15) + 32 * ((p >> 4) & 1); }

template <int WID>
__device__ __forceinline__ void transpose_tile(const Params& p, bf16_t* Wt, int K, int ldw, const float* W, int nt_, int kt_, LAS float* scr, int tid) {
    const int n0 = nt_ * 64, k0 = kt_ * 128;
    {
        const int c4 = (tid & 15) * 4; const int np = n0 + c4; int sc;
        if (WID == 0) { sc = np < 1792 ? np : (np < 1856 ? 1792 + sigma64(np - 1792) : -1); }
        else if (WID == 2) { const int h = np / 192, d = np - h * 192; sc = d < 128 ? np : h * 192 + 128 + sigma64(d - 128); }
        else if (WID == 5) { const int i32 = np & 31; const int jj = (np & 96) + 8 * ((i32 >> 2) & 3) + 4 * (i32 >> 4) + (i32 & 3); sc = ((np >> 7) & 1) * DFF + (np >> 8) * 128 + jj; }
        else sc = np;
        f32x4 v[4];
#pragma unroll
        for (int i = 0; i < 4; ++i) { const int kk = (tid >> 4) + 32 * i; v[i] = sc >= 0 ? __builtin_nontemporal_load((const f32x4*)(W + (size_t)(k0 + kk) * ldw + sc)) : (f32x4){0.f, 0.f, 0.f, 0.f}; }
#pragma unroll
        for (int i = 0; i < 4; ++i) {
            const int kk = (tid >> 4) + 32 * i; const int k = k0 + kk; float ksc = 1.0f;
            if (WID == 2) ksc = p.in[14][k];
            if (WID == 3) ksc = p.in[16][k];
            if (WID == 4) ksc = (k < 1024 ? p.in[18][k] : p.in[19][k - 1024]);
            if (WID == 5) ksc = p.in[21][k];
#pragma unroll
            for (int e = 0; e < 4; ++e) scr[kk * 65 + c4 + e] = v[i][e] * ksc;
        }
    }
    __syncthreads();
#pragma unroll
    for (int j = 0; j < 2; ++j) {
        const int idx = tid + 512 * j; const int r = idx >> 4, kg = (idx & 15) * 8; u32x4 w;
        w.x = cvt_pk(scr[(kg + 0) * 65 + r], scr[(kg + 1) * 65 + r]); w.y = cvt_pk(scr[(kg + 2) * 65 + r], scr[(kg + 3) * 65 + r]);
        w.z = cvt_pk(scr[(kg + 4) * 65 + r], scr[(kg + 5) * 65 + r]); w.w = cvt_pk(scr[(kg + 6) * 65 + r], scr[(kg + 7) * 65 + r]);
        *(u32x4*)(Wt + ((size_t)(n0 + r) * K + k0 + kg)) = w;
    }
    __syncthreads();
}

constexpr int KS_BYTES = 64 * 384, VS_BYTES = 128 * 128, KV_BYTES = KS_BYTES + VS_BYTES;
__device__ __forceinline__ int pi32(int r) { return (r & 0x13) | ((r & 4) << 1) | ((r & 8) >> 1); }

__device__ __forceinline__ void attn_unit(LAS unsigned char* lds, const bf16_t* Q, const bf16_t* KN, const bf16_t* KPE, const bf16_t* VT, bf16_t* Y, float* ssq_b, int b, int h, int qg) {
    const int tid = threadIdx.x, wid = __builtin_amdgcn_readfirstlane(tid >> 6), lane = tid & 63, q = lane & 31, hh = lane >> 5;
    const int t0 = 16 + 256 * qg, c0 = 1 + 4 * qg, cw = c0 + (wid >> 1), ntiles = c0 + 4;
    bf16x8 qf[12];
    {
        const bf16_t* qp = Q + (size_t)(b * 2048 + (t0 - 16) + 32 * wid + q) * 1536 + h * 192 + 8 * hh;
#pragma unroll
        for (int ks = 0; ks < 12; ++ks) qf[ks] = *(const bf16x8*)(qp + 16 * ks);
    }
    f32x16 o[4];
#pragma unroll
    for (int d = 0; d < 4; ++d)
#pragma unroll
        for (int i = 0; i < 16; ++i) o[d][i] = 0.f;
    float mrun = -INFINITY, lsum = 0.f;
    const char* ksrc[3]; unsigned kstr[3]; const char* vsrc[2];
#pragma unroll
    for (int i = 0; i < 3; ++i) {
        const int s = 64 * (wid * 3 + i) + lane; const int key = s / 24, pos = s - key * 24; const int pc = pos ^ ((key >> 1) & 7);
        const size_t row = (size_t)b * 2048 + key;
        if (pc < 16) { ksrc[i] = (const char*)(KN + row * 1024 + h * 128 + pc * 8); kstr[i] = 2048u; }
        else { ksrc[i] = (const char*)(KPE + row * 64 + (pc - 16) * 8); kstr[i] = 128u; }
    }
#pragma unroll
    for (int i = 0; i < 2; ++i) {
        const int s = 64 * (wid * 2 + i) + lane; const int d = s >> 3, pos = s & 7; const int pc = pos ^ ((d >> 1) & 7);
        vsrc[i] = (const char*)(VT + ((size_t)((b * 8 + h) * 128 + d)) * 2048 + pc * 8);
    }
#define AT_DMA(j) do { const int rowoff = (j) == 0 ? (16384 - b * 2048) : 64 * ((j) - 1); const size_t voff = (j) == 0 ? (size_t)(8 - b) * 8 * 128 * 2048 * 2 : (size_t)128 * ((j) - 1); LAS unsigned char* kb_ = lds + ((j) & 1) * KV_BYTES; \
        _Pragma("unroll") for (int i = 0; i < 3; ++i) __builtin_amdgcn_global_load_lds((const unsigned*)(ksrc[i] + (long)rowoff * (long)kstr[i]), (LAS unsigned*)(kb_ + (wid * 3 + i) * 1024), 16, 0, 0); \
        _Pragma("unroll") for (int i = 0; i < 2; ++i) __builtin_amdgcn_global_load_lds((const unsigned*)(vsrc[i] + voff), (LAS unsigned*)(kb_ + KS_BYTES + (wid * 2 + i) * 1024), 16, 0, 0); } while (0)
    const int key0 = pi32(q);
    const unsigned kbase0 = (unsigned)(key0 * 384) + (unsigned)(((hh ^ ((key0 >> 1) & 7))) << 4);
    const unsigned vbase0 = (unsigned)(q * 128) + (unsigned)((hh ^ ((q >> 1) & 7)) << 4);
    AT_DMA(0); __syncthreads();
    for (int j = 0; j < ntiles; ++j) {
        if (j + 1 < ntiles) AT_DMA(j + 1);
        if (j <= cw) {
            const LAS unsigned char* kb = lds + (j & 1) * KV_BYTES; const LAS unsigned char* vb = kb + KS_BYTES;
            f32x16 s0, s1;
#pragma unroll
            for (int i = 0; i < 16; ++i) { s0[i] = 0.f; s1[i] = 0.f; }
            __builtin_amdgcn_s_setprio(1);
            {
                bf16x8 a0n = *(const LAS bf16x8*)(kb + kbase0), a1n = *(const LAS bf16x8*)(kb + (kbase0 + 32u * 384u));
#pragma unroll
                for (int ks = 0; ks < 12; ++ks) {
                    const bf16x8 a0 = a0n, a1 = a1n;
                    if (ks + 1 < 12) { const unsigned off = (kbase0 ^ (unsigned)(((2 * (ks + 1)) & 7) << 4)) + (unsigned)(((2 * (ks + 1)) & 24) << 4);
                        a0n = *(const LAS bf16x8*)(kb + off); a1n = *(const LAS bf16x8*)(kb + (off + 32u * 384u)); }
                    s0 = __builtin_amdgcn_mfma_f32_32x32x16_bf16(a0, qf[ks], s0, 0, 0, 0);
                    s1 = __builtin_amdgcn_mfma_f32_32x32x16_bf16(a1, qf[ks], s1, 0, 0, 0);
                }
            }
            __builtin_amdgcn_s_setprio(0);
            if (j == 0) {
#pragma unroll
                for (int i = 0; i < 16; ++i) { if (i >= 8) s0[i] = -INFINITY; s1[i] = -INFINITY; }
            }
            float mx = s0[0];
#pragma unroll
            for (int i = 1; i < 16; ++i) mx = fmaxf(mx, s0[i]);
#pragma unroll
            for (int i = 0; i < 16; ++i) mx = fmaxf(mx, s1[i]);
            mx = fmaxf(mx, __shfl_xor(mx, 32));
            const bool upd = __builtin_amdgcn_ballot_w64(mx - mrun > 8.0f) != 0ull;
            const float mn = upd ? fmaxf(mrun, mx) : mrun; const float alpha = upd ? fexp2(mrun - mn) : 1.0f; mrun = mn;
            s0 = s0 - mn; s1 = s1 - mn;
#pragma unroll
            for (int i = 0; i < 16; ++i) { s0[i] = fexp2(s0[i]); s1[i] = fexp2(s1[i]); }
            const f32x16 t16 = s0 + s1;
            typedef float f32x8_ __attribute__((ext_vector_type(8)));
            const f32x8_ t8 = __builtin_shufflevector(t16, t16, 0, 1, 2, 3, 4, 5, 6, 7) + __builtin_shufflevector(t16, t16, 8, 9, 10, 11, 12, 13, 14, 15);
            const f32x4 t4 = __builtin_shufflevector(t8, t8, 0, 1, 2, 3) + __builtin_shufflevector(t8, t8, 4, 5, 6, 7);
            const float ps = (t4[0] + t4[1]) + (t4[2] + t4[3]);
            lsum = lsum * alpha + ps;
            if (upd) {
#pragma unroll
                for (int d = 0; d < 4; ++d)
#pragma unroll
                    for (int i = 0; i < 16; ++i) o[d][i] *= alpha;
            }
#pragma unroll
            for (int kb2 = 0; kb2 < 2; ++kb2)
#pragma unroll
                for (int a = 0; a < 2; ++a) {
                    u32x4 pw;
                    if (kb2 == 0) { pw.x = cvt_pk(s0[8 * a + 0], s0[8 * a + 1]); pw.y = cvt_pk(s0[8 * a + 2], s0[8 * a + 3]); pw.z = cvt_pk(s0[8 * a + 4], s0[8 * a + 5]); pw.w = cvt_pk(s0[8 * a + 6], s0[8 * a + 7]); }
                    else { pw.x = cvt_pk(s1[8 * a + 0], s1[8 * a + 1]); pw.y = cvt_pk(s1[8 * a + 2], s1[8 * a + 3]); pw.z = cvt_pk(s1[8 * a + 4], s1[8 * a + 5]); pw.w = cvt_pk(s1[8 * a + 6], s1[8 * a + 7]); }
                    const bf16x8 pf = __builtin_bit_cast(bf16x8, pw);
                    const unsigned vro = vbase0 ^ (unsigned)((4 * kb2 + 2 * a) << 4);
                    __builtin_amdgcn_s_setprio(1);
#pragma unroll
                    for (int db = 0; db < 4; ++db) {
                        const bf16x8 vf = *(const LAS bf16x8*)(vb + (vro + (unsigned)(db * 4096)));
                        o[db] = __builtin_amdgcn_mfma_f32_32x32x16_bf16(vf, pf, o[db], 0, 0, 0);
                    }
                    __builtin_amdgcn_s_setprio(0);
                }
        }
        __syncthreads();
    }
    {
        const float lt = lsum + __shfl_xor(lsum, 32); const float inv = 1.0f / lt;
        const size_t row = (size_t)b * 2048 + (t0 - 16) + 32 * wid + q; float ss = 0.f;
#pragma unroll
        for (int db = 0; db < 4; ++db)
#pragma unroll
            for (int jj = 0; jj < 4; ++jj) {
                f32x4 v; v[0] = o[db][4 * jj] * inv; v[1] = o[db][4 * jj + 1] * inv; v[2] = o[db][4 * jj + 2] * inv; v[3] = o[db][4 * jj + 3] * inv;
                ss += v[0] * v[0] + v[1] * v[1] + v[2] * v[2] + v[3] * v[3];
                *(u32x2*)(Y + (row * 2048 + 1024 + h * 128 + 32 * db + 8 * jj + 4 * hh)) = pack4(v);
            }
        ss += __shfl_xor(ss, 32);
        if (hh == 0 && ssq_b) atomicAdd(ssq_b + row, ss);
    }
#undef AT_DMA
}

__device__ __forceinline__ float dot8(u32x4 a, u32x4 k) {
    return __builtin_bit_cast(float, a.x << 16) * __builtin_bit_cast(float, k.x << 16) + __builtin_bit_cast(float, a.x & 0xffff0000u) * __builtin_bit_cast(float, k.x & 0xffff0000u)
         + __builtin_bit_cast(float, a.y << 16) * __builtin_bit_cast(float, k.y << 16) + __builtin_bit_cast(float, a.y & 0xffff0000u) * __builtin_bit_cast(float, k.y & 0xffff0000u)
         + __builtin_bit_cast(float, a.z << 16) * __builtin_bit_cast(float, k.z << 16) + __builtin_bit_cast(float, a.z & 0xffff0000u) * __builtin_bit_cast(float, k.z & 0xffff0000u)
         + __builtin_bit_cast(float, a.w << 16) * __builtin_bit_cast(float, k.w << 16) + __builtin_bit_cast(float, a.w & 0xffff0000u) * __builtin_bit_cast(float, k.w & 0xffff0000u);
}
__device__ __forceinline__ void attn_meta(LAS unsigned char* lds, const bf16_t* Q, const bf16_t* KN, const bf16_t* KPE, const bf16_t* VT, bf16_t* Y, float* ssq_b, int b, int h) {
    const int tid = threadIdx.x; LAS float* sc = (LAS float*)lds;
    u32x4 va = (u32x4){0u, 0u, 0u, 0u}, vb = va;
    if (tid < 256) { const bf16_t* vp = VT + ((size_t)((64 + h) * 128 + (tid & 127))) * 2048; va = *(const u32x4*)vp; vb = *(const u32x4*)(vp + 8); }
    if (tid < 256) {
        const int qi = tid >> 7, k = (tid >> 3) & 15, part = tid & 7;
        const size_t qrow = (size_t)16384 + 14 + qi, krow = (size_t)16384 + k; float acc = 0.f;
#pragma unroll
        for (int i = 0; i < 3; ++i) { const int pc = part * 3 + i;
            const u32x4 qw = *(const u32x4*)(Q + qrow * 1536 + h * 192 + pc * 8);
            const u32x4 kw = pc < 16 ? *(const u32x4*)(KN + krow * 1024 + h * 128 + pc * 8) : *(const u32x4*)(KPE + krow * 64 + (pc - 16) * 8);
            acc += dot8(qw, kw); }
        acc += __shfl_xor(acc, 1); acc += __shfl_xor(acc, 2); acc += __shfl_xor(acc, 4);
        if (part == 0) sc[qi * 16 + k] = acc;
    }
    __syncthreads();
    if (tid < 256) {
        const int qi = tid >> 7, d = tid & 127; const size_t row = (size_t)16384 + qi;
        float s[16]; float mx = -INFINITY;
#pragma unroll
        for (int k = 0; k < 16; ++k) { s[k] = sc[qi * 16 + k]; mx = fmaxf(mx, s[k]); }
        float l = 0.f;
#pragma unroll
        for (int k = 0; k < 16; ++k) { s[k] = fexp2(s[k] - mx); l += s[k]; }
        float a = s[0] * __builtin_bit_cast(float, va.x << 16) + s[1] * __builtin_bit_cast(float, va.x & 0xffff0000u) + s[2] * __builtin_bit_cast(float, va.y << 16) + s[3] * __builtin_bit_cast(float, va.y & 0xffff0000u)
                + s[4] * __builtin_bit_cast(float, va.z << 16) + s[5] * __builtin_bit_cast(float, va.z & 0xffff0000u) + s[6] * __builtin_bit_cast(float, va.w << 16) + s[7] * __builtin_bit_cast(float, va.w & 0xffff0000u)
                + s[8] * __builtin_bit_cast(float, vb.x << 16) + s[9] * __builtin_bit_cast(float, vb.x & 0xffff0000u) + s[10] * __builtin_bit_cast(float, vb.y << 16) + s[11] * __builtin_bit_cast(float, vb.y & 0xffff0000u)
                + s[12] * __builtin_bit_cast(float, vb.z << 16) + s[13] * __builtin_bit_cast(float, vb.z & 0xffff0000u) + s[14] * __builtin_bit_cast(float, vb.w << 16) + s[15] * __builtin_bit_cast(float, vb.w & 0xffff0000u);
        a = a / l;
        Y[row * 2048 + 1024 + h * 128 + d] = (bf16_t)(cvt_pk(a, 0.f) & 0xffff);
        const float ss = wave_sum(a * a);
        if ((tid & 63) == 0 && ssq_b) atomicAdd(ssq_b + row, ss);
    }
    __syncthreads();
}


#define XB_TMO      128
#define XB_XCNT(j)  (256  + 64 * (j))
#define XB_XSUB(j)  (1280 + 64 * (j))
#define XB_XGEN(j)  (2304 + 64 * (j))
#define XB_TOP      3328
#define XB_TOPGEN   3392
#define XCD_BAR_WORDS 3456
#define XB_SPIN_CAP (1u << 18)
__device__ __forceinline__ unsigned xb_ld(unsigned* p)              { return __hip_atomic_load(p, __ATOMIC_RELAXED, __HIP_MEMORY_SCOPE_AGENT); }
__device__ __forceinline__ unsigned xb_add(unsigned* p, unsigned v) { return __hip_atomic_fetch_add(p, v, __ATOMIC_RELAXED, __HIP_MEMORY_SCOPE_AGENT); }
__device__ __forceinline__ unsigned xb_xcc_id() { return (unsigned)__builtin_amdgcn_s_getreg((3 << 11) | 20) & 0xFu; }
#define XB_SPIN(cond, bar) do { unsigned _sp = 0; while (cond) { __builtin_amdgcn_s_sleep(1); \
    if ((++_sp & 255u) == 0u) { if (xb_ld(&(bar)[XB_TMO])) break; if (_sp > XB_SPIN_CAP) { atomicAdd(&(bar)[XB_TMO], 1u); break; } } } } while (0)
struct XcdBarrier { unsigned* bar; unsigned x; volatile LAS unsigned* st; };
__device__ __forceinline__ XcdBarrier xcd_barrier_post(unsigned* bar, volatile LAS unsigned* st) {
    XcdBarrier b; b.bar = bar; b.x = xb_xcc_id(); b.st = st;
    if (threadIdx.x == 0) (void)xb_add(&bar[XB_XCNT(b.x)], 1u);
    return b;
}
__device__ __forceinline__ void xcd_barrier_complete(unsigned* bar, unsigned x, unsigned& nloc, unsigned& nx) {
    const unsigned G = gridDim.x * gridDim.y * gridDim.z;
    unsigned sum, cnt, mine, sp = 0u;
    for (;;) {
        sum = 0u; cnt = 0u; mine = 0u;
#pragma unroll
        for (unsigned j = 0; j < 16; ++j) { const unsigned c = xb_ld(&bar[XB_XCNT(j)]); sum += c; cnt += (c > 0u) ? 1u : 0u; mine = (j == x) ? c : mine; }
        if (sum == G) break;
        __builtin_amdgcn_s_sleep(1);
        if ((++sp & 255u) == 0u) { if (xb_ld(&bar[XB_TMO])) break; if (sp > XB_SPIN_CAP) { atomicAdd(&bar[XB_TMO], 1u); break; } }
    }
    nloc = mine > 0u ? mine : 1u; nx = cnt > 0u ? cnt : 1u;
}
__device__ __forceinline__ void xcd_barrier(const XcdBarrier& b) {
    asm volatile("s_waitcnt vmcnt(0)" ::: "memory");
    __syncthreads();
    if (threadIdx.x == 0) {
        unsigned* bar = b.bar;
        __builtin_amdgcn_s_waitcnt(0);
        unsigned nloc = b.st[0], nx = b.st[1];
        if (nloc == 0u) { xcd_barrier_complete(bar, b.x, nloc, nx); b.st[0] = nloc; b.st[1] = nx; }
        const unsigned old = xb_add(&bar[XB_XSUB(b.x)], 1u);
        const unsigned gen = old / nloc;
        if (old + 1u == (gen + 1u) * nloc) {
            __builtin_amdgcn_fence(__ATOMIC_RELEASE, "agent");
            asm volatile("s_waitcnt vmcnt(0)" ::: "memory");
            const unsigned og = xb_add(&bar[XB_TOP], 1u);
            const unsigned tg = og / nx;
            if (og + 1u == (tg + 1u) * nx) xb_add(&bar[XB_TOPGEN], 1u);
            else XB_SPIN(xb_ld(&bar[XB_TOPGEN]) == tg, bar);
            __builtin_amdgcn_fence(__ATOMIC_ACQUIRE, "agent");
            xb_add(&bar[XB_XGEN(b.x)], 1u);
            asm volatile("s_waitcnt vmcnt(0)" ::: "memory");
        } else {
            XB_SPIN(xb_ld(&bar[XB_XGEN(b.x)]) == gen, bar);
            __builtin_amdgcn_fence(__ATOMIC_ACQUIRE, "agent");
            asm volatile("s_waitcnt vmcnt(0)" ::: "memory");
        }
    }
    __syncthreads();
}

__global__ void __launch_bounds__(NTHR, 2) fwd_megakernel(Params p) {
    extern __shared__ __attribute__((aligned(16))) unsigned char smem[];
    LAS unsigned char* lds = (LAS unsigned char*)smem;
    cg::grid_group grid = cg::this_grid();
    const int tid = threadIdx.x, lane = tid & 63, wid = tid >> 6, G = gridDim.x, bid = blockIdx.x;
    const long gtid = (long)bid * NTHR + tid, gthreads = (long)G * NTHR;
    unsigned char* ws = p.ws;
    bf16_t* WinT = (bf16_t*)(ws + O_WIN); bf16_t* WgluT = (bf16_t*)(ws + O_WGLU); bf16_t* WqT = (bf16_t*)(ws + O_WQ); bf16_t* WkvT = (bf16_t*)(ws + O_WKV);
    bf16_t* WoutT = (bf16_t*)(ws + O_WOUT); bf16_t* WupT = (bf16_t*)(ws + O_WUP); bf16_t* WdT = (bf16_t*)(ws + O_WD);
    bf16_t* MST = (bf16_t*)(ws + O_MST); bf16_t* MIO = (bf16_t*)(ws + O_MIO); float* KD = (float*)(ws + O_KD);
    float2* PWC = (float2*)(ws + O_PWC); float2* PW1 = (float2*)(ws + O_PW1); float* COS = (float*)(ws + O_COS); float* SIN = (float*)(ws + O_SIN);
    float* ssq_q = (float*)(ws + O_SSQ); float* ssq_kv = ssq_q + MPAD; float* ssq_a = ssq_kv + MPAD; float* ssq_b = ssq_a + MPAD; float* ssq_h = ssq_b + MPAD; float* ssq_o = ssq_h + MPAD; float* rinvx = ssq_o + MPAD;
    bf16_t* Y = (bf16_t*)(ws + O_Y); bf16_t* XN = (bf16_t*)(ws + O_XN); bf16_t* XS = (bf16_t*)(ws + O_XS); bf16_t* QA = (bf16_t*)(ws + O_QA); bf16_t* KVA = (bf16_t*)(ws + O_KVA);
    bf16_t* KPE = (bf16_t*)(ws + O_KPE); bf16_t* Qb = (bf16_t*)(ws + O_Q); bf16_t* KN = (bf16_t*)(ws + O_KN); bf16_t* VT = (bf16_t*)(ws + O_VT); float* Sst = (float*)(ws + O_S);
    bf16_t* Gb = (bf16_t*)(ws + O_G); bf16_t* XH = (bf16_t*)(ws + O_XH); bf16_t* ACT = (bf16_t*)(ws + O_ACT);
    const float* x = p.in[0]; const float* meta = p.in[1];
    unsigned* barw = (unsigned*)(ws + O_BAR);
    volatile LAS unsigned* bst = (volatile LAS unsigned*)(lds + STAGE_BYTES + 16384);
    if (tid < 4) bst[tid] = 0u;
    __syncthreads();
    XcdBarrier xbar; xbar.bar = barw; xbar.x = 0; xbar.st = bst;

#if PH_ON(0)
#pragma unroll 1
    for (int rep = 0; rep < 1 + DUP_ON(0); ++rep)
    {
        for (long i = gtid; i < 6 * MPAD; i += gthreads) ssq_q[i] = 0.f;
        if (bid == 0) for (int i = tid; i < 4096; i += NTHR) barw[i] = 0u;
        for (long i = gtid; i < 1024 * 6; i += gthreads) { const int r = (int)(i / 6), pc = (int)(i % 6); *(u32x4*)(VT + ((size_t)(64 * 128 + r)) * 2048 + 16 + pc * 8) = (u32x4){0u, 0u, 0u, 0u}; }
        for (long i = gtid; i < LL * 32; i += gthreads) { const int pos = (int)(i >> 5), j = (int)(i & 31); const float invf = 1.0f / powf(10000.0f, (float)(2 * j) / 64.0f); const float ang = (float)pos * invf; COS[i] = cosf(ang); SIN[i] = sinf(ang); }
        for (long idx = gthreads - 1 - gtid; idx < 4096 * 16; idx += gthreads) {
            const long i = idx >> 4; const int d = (int)(idx & 15); const int g = (int)(i >> 6);
            const float lr = p.in[4][i], li = p.in[5][i], dt = expf(p.in[6][g]); const float zr = lr * dt, zi = li * dt;
            const float er = expf(zr); const float lbr = er * cosf(zi), lbi = er * sinf(zi);
            const float nr = lbr - 1.0f, ni = lbi, den = lr * lr + li * li;
            const float cr = (nr * lr + ni * li) / den, ci = (ni * lr - nr * li) / den;
            const float e0 = expf(zr * (float)d), a0 = zi * (float)d; const float pr = e0 * cosf(a0), pi = e0 * sinf(a0);
            PWC[idx] = make_float2(pr * cr - pi * ci, pr * ci + pi * cr);
            const float e1 = expf(zr * (float)(d + 1)), a1 = zi * (float)(d + 1);
            PW1[idx] = make_float2(e1 * cosf(a1), e1 * sinf(a1));
        }
        for (int row = bid * 8 + wid; row < 16384 + NMETA; row += G * 8) {
            bf16_t* orow = XN + (size_t)row * 2048;
            const float* hrow = (row >= 16384) ? meta + (size_t)(row - 16384) * 2048 : x + (size_t)row * 2048;
            f32x4 v[8]; float ss = 0.f;
#pragma unroll
            for (int i = 0; i < 4; ++i) { v[2 * i] = __builtin_nontemporal_load((const f32x4*)(hrow + i * 512 + lane * 8)); v[2 * i + 1] = __builtin_nontemporal_load((const f32x4*)(hrow + i * 512 + lane * 8 + 4)); }
#pragma unroll
            for (int i = 0; i < 8; ++i) ss += v[i][0] * v[i][0] + v[i][1] * v[i][1] + v[i][2] * v[i][2] + v[i][3] * v[i][3];
            ss = wave_sum(ss); const float rs = rsqrtf(ss * (1.0f / 2048.0f) + EPS);
            if (lane == 0) rinvx[row] = 1.0f / rs;
#pragma unroll
            for (int i = 0; i < 4; ++i) {
                const f32x4 g0 = *(const f32x4*)(p.in[2] + i * 512 + lane * 8), g1 = *(const f32x4*)(p.in[2] + i * 512 + lane * 8 + 4);
                const f32x4 a = v[2 * i] * rs * g0, c = v[2 * i + 1] * rs * g1; u32x4 w; w.x = cvt_pk(a[0], a[1]); w.y = cvt_pk(a[2], a[3]); w.z = cvt_pk(c[0], c[1]); w.w = cvt_pk(c[2], c[3]);
                *(u32x4*)(orow + i * 512 + lane * 8) = w;
            }
        }
        LAS float* scr = (LAS float*)lds;
        constexpr int T0 = 32 * 16, T1 = T0 + 16 * 8, T2 = T1 + 24 * 4, T3 = T2 + 32 * 2, T4 = T3 + 32 * 16, T5 = T4 + 172 * 16, T6 = T5 + 32 * 43;
        for (int it = bid; it < T6; it += G) {
            if (it < T0) { transpose_tile<0>(p, WinT, 2048, 1856, p.in[3], it % 32, it / 32, scr, tid); }
            else if (it < T1) { const int j = it - T0; transpose_tile<1>(p, WgluT, 1024, 1024, p.in[12], j % 16, j / 16, scr, tid); }
            else if (it < T2) { const int j = it - T1; transpose_tile<2>(p, WqT, 512, 1536, p.in[15], j % 24, j / 24, scr, tid); }
            else if (it < T3) { const int j = it - T2; transpose_tile<3>(p, WkvT, 256, 2048, p.in[17], j % 32, j / 32, scr, tid); }
            else if (it < T4) { const int j = it - T3; transpose_tile<4>(p, WoutT, 2048, 2048, p.in[20], j % 32, j / 32, scr, tid); }
            else if (it < T5) { const int j = it - T4; transpose_tile<5>(p, WupT, 2048, 2 * DFF, p.in[22], j % 172, j / 172, scr, tid); }
            else { const int j = it - T5; transpose_tile<6>(p, WdT, DFF, 2048, p.in[25], j % 32, j / 32, scr, tid); }
        }
    grid.sync();
    if (rep == 0) xbar = xcd_barrier_post(barw, bst);
    }

#endif
#if PH_ON(1)
#pragma unroll 1
    for (int rep = 0; rep < 1 + DUP_ON(1); ++rep)
    {
        const float* b_re = p.in[7]; const float* b_im = p.in[8]; const float* c_re = p.in[9]; const float* c_im = p.in[10];
        {
            LAS float* Bre = (LAS float*)lds; LAS float* Bim = Bre + 1024; LAS float* Cre = Bim + 1024; LAS float* Cim = Cre + 1024; LAS float* Wre = Cim + 1024; LAS float* Wim = Wre + 256;
            for (int wi = bid; wi < 256; wi += G) {
                const int g = wi >> 2, dq = wi & 3;
                if (tid < 256) {
                    ((LAS f32x4*)Bre)[tid] = ((const f32x4*)(b_re + g * 1024))[tid]; ((LAS f32x4*)Bim)[tid] = ((const f32x4*)(b_im + g * 1024))[tid];
                    ((LAS f32x4*)Cre)[tid] = ((const f32x4*)(c_re + g * 1024))[tid]; ((LAS f32x4*)Cim)[tid] = ((const f32x4*)(c_im + g * 1024))[tid];
                    const int q = tid & 63, dd = tid >> 6; const float2 w = PWC[(g * 64 + q) * 16 + 4 * dq + dd]; Wre[dd * 64 + q] = w.x; Wim[dd * 64 + q] = w.y;
                }
                __syncthreads();
#pragma unroll
                for (int j = 0; j < 2; ++j) {
                    const int o = tid + 512 * j, dd = o >> 8, c = (o >> 4) & 15, c2 = o & 15; float acc = 0.f;
#pragma unroll 8
                    for (int q = 0; q < 64; ++q) {
                        const float cr = Cre[c * 64 + q], ci = Cim[c * 64 + q], wr_ = Wre[dd * 64 + q], wi_ = Wim[dd * 64 + q];
                        const float tr = cr * wr_ - ci * wi_, ti = cr * wi_ + ci * wr_;
                        acc += tr * Bre[q * 16 + c2] - ti * Bim[q * 16 + c2];
                    }
                    KD[((g * 16 + 4 * dq + dd) * 16 + c) * 16 + c2] = acc;
                }
                __syncthreads();
            }
        }
        for (long i = gtid; i < (long)64 * 256 * 16; i += gthreads) {
            const int g = (int)(i >> 12), n = (int)(i >> 4) & 255, sx = (int)i & 15; u32x4 o0 = (u32x4){0u, 0u, 0u, 0u}, o1 = o0;
            if (n < 128) {
                const int q = n & 63; const float2 w = PWC[(g * 64 + q) * 16 + (15 - sx)];
                const float* brp = b_re + (g * 64 + q) * 16; const float* bip = b_im + (g * 64 + q) * 16; float v[16];
#pragma unroll
                for (int e = 0; e < 4; ++e) { const f32x4 br = *(const f32x4*)(brp + 4 * e), bi = *(const f32x4*)(bip + 4 * e);
#pragma unroll
                    for (int u2 = 0; u2 < 4; ++u2) v[4 * e + u2] = (n < 64) ? (w.x * br[u2] - w.y * bi[u2]) : (w.x * bi[u2] + w.y * br[u2]); }
                o0.x = cvt_pk(v[0], v[1]); o0.y = cvt_pk(v[2], v[3]); o0.z = cvt_pk(v[4], v[5]); o0.w = cvt_pk(v[6], v[7]);
                o1.x = cvt_pk(v[8], v[9]); o1.y = cvt_pk(v[10], v[11]); o1.z = cvt_pk(v[12], v[13]); o1.w = cvt_pk(v[14], v[15]);
            }
            u32x4* dst = (u32x4*)(MST + ((size_t)(g * 256 + n) * 256 + sx * 16)); dst[0] = o0; dst[1] = o1;
        }
        for (long i = gtid; i < (long)64 * 256 * 8; i += gthreads) {
            const int g = (int)(i >> 11), n = (int)(i >> 3) & 255, j = (int)i & 7; const int kk0 = 16 * j, q0 = kk0 & 63, t = n >> 4, c = n & 15; const bool neg = kk0 >= 64;
            const float* crp = c_re + (g * 16 + c) * 64 + q0; const float* cip = c_im + (g * 16 + c) * 64 + q0;
            f32x4 cr[4], ci[4]; float2 w[16];
#pragma unroll
            for (int e = 0; e < 4; ++e) { cr[e] = *(const f32x4*)(crp + 4 * e); ci[e] = *(const f32x4*)(cip + 4 * e); }
#pragma unroll
            for (int e = 0; e < 16; ++e) w[e] = PW1[(g * 64 + q0 + e) * 16 + t];
            float v[16];
#pragma unroll
            for (int e = 0; e < 16; ++e) { const float a = cr[e >> 2][e & 3], bq = ci[e >> 2][e & 3]; v[e] = neg ? -(a * w[e].y + bq * w[e].x) : (a * w[e].x - bq * w[e].y); }
            u32x4 o0, o1; o0.x = cvt_pk(v[0], v[1]); o0.y = cvt_pk(v[2], v[3]); o0.z = cvt_pk(v[4], v[5]); o0.w = cvt_pk(v[6], v[7]);
            o1.x = cvt_pk(v[8], v[9]); o1.y = cvt_pk(v[10], v[11]); o1.z = cvt_pk(v[12], v[13]); o1.w = cvt_pk(v[14], v[15]);
            u32x4* dst = (u32x4*)(MIO + ((size_t)(g * 256 + n) * XSK + 256 + kk0)); dst[0] = o0; dst[1] = o1;
        }
        {
            LAS f32x4* red = (LAS f32x4*)lds;
            const int fr = lane & 15, fq = lane >> 4;
            for (int task = bid; task < 114; task += G) {
                const bool pair = task >= 112;
                const int g0 = pair ? 112 + 2 * (task - 112) : task;
                f32x4 c0 = (f32x4){0.f, 0.f, 0.f, 0.f}, c1 = c0;
#pragma unroll
                for (int i = 0; i < 8; ++i) {
                    const int k = wid * 256 + i * 32 + 8 * fq;
                    const bf16x8 af = *(const bf16x8*)(XN + (size_t)(16384 + fr) * 2048 + k);
                    const bf16x8 b0 = *(const bf16x8*)(WinT + (size_t)(g0 * 16 + fr) * 2048 + k);
                    c0 = __builtin_amdgcn_mfma_f32_16x16x32_bf16(b0, af, c0, 0, 0, 0);
                    if (pair) { const bf16x8 b1 = *(const bf16x8*)(WinT + (size_t)(g0 * 16 + 16 + fr) * 2048 + k); c1 = __builtin_amdgcn_mfma_f32_16x16x32_bf16(b1, af, c1, 0, 0, 0); }
                }
                red[wid * 64 + lane] = c0; red[512 + wid * 64 + lane] = c1;
                __syncthreads();
                if (wid == 0) {
                    f32x4 v0 = red[lane], v1 = red[512 + lane];
#pragma unroll
                    for (int w2 = 1; w2 < 8; ++w2) { v0 += red[w2 * 64 + lane]; v1 += red[512 + w2 * 64 + lane]; }
                    const int t = fr;
                    if (g0 < 64) { *(u32x2*)(XS + ((size_t)(g0 * GRP + 1024)) * XSK + t * 16 + 4 * fq) = pack4(v0); }
                    else if (g0 < 112) {
                        float ss = v0[0] * v0[0] + v0[1] * v0[1] + v0[2] * v0[2] + v0[3] * v0[3];
                        if (g0 < 96) *(u32x2*)(QA + (size_t)(16384 + t) * 512 + (g0 - 64) * 16 + 4 * fq) = pack4(v0);
                        else *(u32x2*)(KVA + (size_t)(16384 + t) * 256 + (g0 - 96) * 16 + 4 * fq) = pack4(v0);
                        ss += __shfl_xor(ss, 16); ss += __shfl_xor(ss, 32);
                        if (fq == 0) atomicAdd((g0 < 96 ? ssq_q : ssq_kv) + 16384 + t, ss);
                    } else {
                        const int pp = 32 * (task - 112) + 4 * fq, j = 16 * (task - 112) + 4 * fq;
                        const f32x4 c = *(const f32x4*)(COS + t * 32 + j), sn_ = *(const f32x4*)(SIN + t * 32 + j); f32x4 y1, y2;
#pragma unroll
                        for (int e = 0; e < 4; ++e) { y1[e] = v0[e] * c[e] - v1[e] * sn_[e]; y2[e] = v1[e] * c[e] + v0[e] * sn_[e]; }
                        *(u32x2*)(KPE + (size_t)(16384 + t) * 64 + pp) = pack4(y1); *(u32x2*)(KPE + (size_t)(16384 + t) * 64 + pp + 16) = pack4(y2);
                    }
                }
                __syncthreads();
            }
        }
        GSched<0> S; S.init(XN, WinT, 2048, 2048, 64, 8, 1, 0, 0);
        EpiZ E{XS, QA, KVA, KPE, rep ? nullptr : ssq_q, ssq_kv, COS, SIN};
        gemm_phase(lds, S, E);
    xcd_barrier(xbar);
    }

#endif
#if PH_ON(2)
    {
        for (long i = gtid; i < (long)64 * 256 * 16; i += gthreads) {
            const int g = (int)(i >> 12), n = (int)(i >> 4) & 255, sx = (int)i & 15; const int t = n >> 4, c = n & 15;
            u32x4 o0 = (u32x4){0u, 0u, 0u, 0u}, o1 = o0;
            if (sx <= t) { const float* kp = KD + ((g * 16 + (t - sx)) * 16 + c) * 16; const f32x4 a0 = *(const f32x4*)kp, a1 = *(const f32x4*)(kp + 4), a2 = *(const f32x4*)(kp + 8), a3 = *(const f32x4*)(kp + 12);
                o0.x = cvt_pk(a0[0], a0[1]); o0.y = cvt_pk(a0[2], a0[3]); o0.z = cvt_pk(a1[0], a1[1]); o0.w = cvt_pk(a1[2], a1[3]);
                o1.x = cvt_pk(a2[0], a2[1]); o1.y = cvt_pk(a2[2], a2[3]); o1.z = cvt_pk(a3[0], a3[1]); o1.w = cvt_pk(a3[2], a3[3]); }
            u32x4* dst = (u32x4*)(MIO + ((size_t)(g * 256 + n) * XSK + sx * 16)); dst[0] = o0; dst[1] = o1;
        }
        for (int col = bid * 8 + wid; col < 2048; col += G * 8) {
            const u32x2 w = *(const u32x2*)(WkvT + (size_t)col * 256 + lane * 4); float v = 0.f;
#pragma unroll
            for (int r = 0; r < 16; ++r) { const float s_ = wave_sum(dot4(*(const u32x2*)(KVA + (size_t)(16384 + r) * 256 + lane * 4), w)); if (lane == r) v = s_; }
            if (lane < 16) { v *= rsqrtf(ssq_kv[16384 + lane] * (1.0f / 256.0f) + EPS); const int hd = col >> 8, wi = col & 255;
                if (wi < 128) KN[(size_t)(16384 + lane) * 1024 + hd * 128 + wi] = f2bf(v); else VT[((size_t)((64 + hd) * 128 + wi - 128)) * 2048 + lane] = f2bf(v); }
        }
        for (int task = bid * 8 + wid; task < 1280; task += G * 8) {
            const bool pair = task >= 1024; int n0, n1, j = 0;
            if (!pair) { n0 = 192 * (task >> 7) + (task & 127); n1 = n0; }
            else { const int pidx = task - 1024, hq = pidx >> 5, pq = pidx & 31, pp = (pq >> 4) * 32 + (pq & 15); n0 = 192 * hq + 128 + pp; n1 = n0 + 16; j = (pp >> 5) * 16 + (pp & 15); }
            const u32x4 w0 = *(const u32x4*)(WqT + (size_t)n0 * 512 + lane * 8), w1 = *(const u32x4*)(WqT + (size_t)n1 * 512 + lane * 8);
            const u32x4 x0 = *(const u32x4*)(QA + (size_t)(16384 + 14) * 512 + lane * 8), x1 = *(const u32x4*)(QA + (size_t)(16384 + 15) * 512 + lane * 8);
            const float p00 = wave_sum(dot8(x0, w0)), p01 = wave_sum(dot8(x0, w1)), p10 = wave_sum(dot8(x1, w0)), p11 = wave_sum(dot8(x1, w1));
            if (lane < 2) { const int t = 14 + lane; const float rs = rsqrtf(ssq_q[16384 + t] * (1.0f / 512.0f) + EPS) * QSCALE;
                float y0 = (lane ? p10 : p00) * rs, y1 = (lane ? p11 : p01) * rs;
                if (pair) { const float c = COS[t * 32 + j], sn_ = SIN[t * 32 + j]; const float z0 = y0 * c - y1 * sn_, z1 = y1 * c + y0 * sn_; y0 = z0; y1 = z1; }
                Qb[(size_t)(16384 + t) * 1536 + n0] = f2bf(y0); if (pair) Qb[(size_t)(16384 + t) * 1536 + n1] = f2bf(y1); }
        }
        for (int t4 = (bid * 8 + wid) * 4; t4 < 64 * 128; t4 += G * 32) {
            const int g = t4 >> 7, n0_ = t4 & 127;
            const u32x2 xv = *(const u32x2*)(XS + ((size_t)(g * GRP + 1024)) * XSK + lane * 4);
            u32x2 mv[4];
#pragma unroll
            for (int i = 0; i < 4; ++i) mv[i] = *(const u32x2*)(MST + ((size_t)(g * 256 + n0_ + i)) * 256 + lane * 4);
            float r4[4];
#pragma unroll
            for (int i = 0; i < 4; ++i) r4[i] = wave_sum(dot4(xv, mv[i]));
            if (lane == 0) *(f32x4*)(Sst + ((size_t)(g * GRP + 1024)) * 128 + n0_) = (f32x4){r4[0], r4[1], r4[2], r4[3]};
        }
        { GSched<0> S; S.init(QA, WqT, 512, 512, 64, 6, 1, 0, 0); EpiQ E{Qb, ssq_q, COS, SIN}; gemm_phase(lds, S, E); }
        { GSched<0> S; S.init(KVA, WkvT, 256, 256, 64, 8, 1, 0, 0); EpiKV E{KN, VT, ssq_kv}; gemm_phase(lds, S, E); }
        { GSched<0> S; S.init(XS, MST, XSK, 256, 4, 1, 64, (size_t)GRP * XSK * 2, (size_t)256 * 256 * 2); EpiS E{Sst}; gemm_phase(lds, S, E); }
    }
    xcd_barrier(xbar);

#endif
#if PH_ON(3)
#pragma unroll 1
    for (int rep = 0; rep < 1 + DUP_ON(3); ++rep)
    {
        float* ssq_b_ = rep ? nullptr : ssq_b;
#ifndef NO_SCAN
        {
            LAS float* tb = (LAS float*)lds;
            for (int base = bid * 128; base < NB * 64 * 64; base += G * 128) {
                const int cl = tid & 127, seg = tid >> 7, ch = base + cl;
                const int q = ch & 63, g = (ch >> 6) & 63, b = ch >> 12;
                const float2 l16 = PW1[(g * 64 + q) * 16 + 15];
                const float* sp = Sst + ((size_t)(g * GRP + b * 128 + 32 * seg)) * 128 + q; bf16_t* xp = XS + ((size_t)(g * GRP + b * 128 + 32 * seg)) * XSK + 256 + q;
                float sr[32], si[32];
#pragma unroll
                for (int k = 0; k < 32; ++k) { sr[k] = sp[(size_t)k * 128]; si[k] = sp[(size_t)k * 128 + 64]; }
                float hr = 0.f, hi = 0.f;
#pragma unroll
                for (int k = 0; k < 32; ++k) { const float nr = l16.x * hr - l16.y * hi + sr[k], ni = l16.x * hi + l16.y * hr + si[k]; hr = nr; hi = ni; }
                tb[(seg * 128 + cl) * 2] = hr; tb[(seg * 128 + cl) * 2 + 1] = hi;
                __syncthreads();
                float pr = l16.x, pi = l16.y;
#pragma unroll
                for (int e = 0; e < 5; ++e) { const float nr = pr * pr - pi * pi, ni = 2.0f * pr * pi; pr = nr; pi = ni; }
                hr = Sst[((size_t)(g * GRP + 1024)) * 128 + q]; hi = Sst[((size_t)(g * GRP + 1024)) * 128 + 64 + q];
#pragma unroll
                for (int s2 = 0; s2 < 3; ++s2) { if (s2 < seg) { const float t2x = tb[(s2 * 128 + cl) * 2], t2y = tb[(s2 * 128 + cl) * 2 + 1]; const float nr = pr * hr - pi * hi + t2x, ni = pr * hi + pi * hr + t2y; hr = nr; hi = ni; } }
#pragma unroll
                for (int k = 0; k < 32; ++k) {
                    xp[(size_t)k * XSK] = f2bf(hr); xp[(size_t)k * XSK + 64] = f2bf(hi);
                    const float nr = l16.x * hr - l16.y * hi + sr[k], ni = l16.x * hi + l16.y * hr + si[k]; hr = nr; hi = ni;
                }
                __syncthreads();
            }
        }
#endif
#ifndef NO_ATTN
        for (int pid = bid; pid < 256; pid += G) {
            const int bh = (pid & 7) * 8 + (pid >> 5), xq = (pid >> 3) & 3;
            attn_unit(lds, Qb, KN, KPE, VT, Y, ssq_b_, bh >> 3, bh & 7, 7 - xq);
            attn_unit(lds, Qb, KN, KPE, VT, Y, ssq_b_, bh >> 3, bh & 7, xq);
        }
#endif
#ifndef NO_META
        for (int pid = bid; pid < 8; pid += G) attn_meta(lds, Qb, KN, KPE, VT, Y, ssq_b_, 0, pid);
#endif
    xcd_barrier(xbar);
    }

#endif
#if PH_ON(4)
    for (int task = bid * 8 + wid; task < 2048; task += G * 8) {
        const int g = task >> 5, i2 = (task >> 4) & 1, c = task & 15, n = (14 + i2) * 16 + c;
        const float v = wave_sum(dot4(*(const u32x2*)(XS + ((size_t)(g * GRP + 1024)) * XSK + lane * 4), *(const u32x2*)(MIO + ((size_t)(g * 256 + n)) * XSK + lane * 4)));
        if (lane == 0) { const float a = v + p.in[11][g * 16 + c] * bf2f(XS[((size_t)(g * GRP + 1024)) * XSK + n]);
            Gb[(size_t)(16384 + i2) * 1024 + g * 16 + c] = f2bf(a * sigmoidf_(1.5957691216f * (a + 0.044715f * a * a * a))); }
    }
    { GSched<0> S; S.init(XS, MIO, XSK, XSK, 4, 1, 64, (size_t)GRP * XSK * 2, (size_t)256 * XSK * 2); EpiY E{XS, Gb, p.in[11]}; gemm_phase(lds, S, E); }
    xcd_barrier(xbar);

#endif
#if PH_ON(5)
    {
        LAS float* red = (LAS float*)lds;
        for (int c0_ = bid * 4; c0_ < 1024; c0_ += G * 4) {
            float ssl0 = 0.f, ssl1 = 0.f;
            if (wid < 4) {
                const int col = c0_ + wid; float a0 = 0.f, a1 = 0.f;
#pragma unroll
                for (int hk = 0; hk < 2; ++hk) { const int k = lane * 16 + hk * 8;
                    const u32x4 w = *(const u32x4*)(WgluT + (size_t)col * 1024 + k);
                    a0 += dot8(*(const u32x4*)(Gb + (size_t)16384 * 1024 + k), w); a1 += dot8(*(const u32x4*)(Gb + (size_t)16385 * 1024 + k), w); }
                a0 = wave_sum(a0); a1 = wave_sum(a1);
                const float bb = p.in[13][col];
                const float o0 = bf2f(Gb[(size_t)16384 * 1024 + col]) * sigmoidf_(a0 + bb), o1 = bf2f(Gb[(size_t)16385 * 1024 + col]) * sigmoidf_(a1 + bb);
                if (lane == 0) { Y[(size_t)16384 * 2048 + col] = (bf16_t)(cvt_pk(o0, 0.f) & 0xffff); Y[(size_t)16385 * 2048 + col] = (bf16_t)(cvt_pk(o1, 0.f) & 0xffff); }
                ssl0 = o0 * o0; ssl1 = o1 * o1;
            }
            if (lane == 0) { red[wid * 2] = ssl0; red[wid * 2 + 1] = ssl1; }
            __syncthreads();
            if (tid < 2) { float t_ = 0.f; for (int w2 = 0; w2 < 8; ++w2) t_ += red[w2 * 2 + tid]; atomicAdd(ssq_a + 16384 + tid, t_); }
            __syncthreads();
        }
    }
    { GSched<0> S; S.init(Gb, WgluT, 1024, 1024, 64, 4, 1, 0, 0); EpiGlu E{Gb, Y, p.in[13], ssq_a}; gemm_phase(lds, S, E); }
    xcd_barrier(xbar);

#endif
#if PH_ON(6)
    {
        LAS float* red = (LAS float*)lds;
        const float sc0 = (lane < 32) ? rsqrtf(ssq_a[16384] * (1.0f / 1024.0f) + EPS) : rsqrtf(ssq_b[16384] * (1.0f / 1024.0f) + EPS);
        const float sc1 = (lane < 32) ? rsqrtf(ssq_a[16385] * (1.0f / 1024.0f) + EPS) : rsqrtf(ssq_b[16385] * (1.0f / 1024.0f) + EPS);
        for (int c0_ = bid * 8; c0_ < 2048; c0_ += G * 8) {
            const int col = c0_ + wid; float a0 = 0.f, a1 = 0.f;
#pragma unroll
            for (int hk = 0; hk < 4; ++hk) { const int k = lane * 32 + hk * 8;
                const u32x4 w = *(const u32x4*)(WoutT + (size_t)col * 2048 + k);
                a0 += dot8(*(const u32x4*)(Y + (size_t)16384 * 2048 + k), w); a1 += dot8(*(const u32x4*)(Y + (size_t)16385 * 2048 + k), w); }
            a0 *= sc0; a1 *= sc1;
            a0 = wave_sum(a0); a1 = wave_sum(a1);
            const float h0 = meta[(size_t)14 * 2048 + col] + a0, h1v = meta[(size_t)15 * 2048 + col] + a1;
            if (lane < 16) { const int bb = lane >> 1, ii = lane & 1; XH[(size_t)(bb * XHB + ii) * 2048 + col] = (bf16_t)(cvt_pk(ii ? h1v : h0, 0.f) & 0xffff); }
            if (lane == 0) { red[wid * 2] = h0 * h0; red[wid * 2 + 1] = h1v * h1v; }
            __syncthreads();
            if (tid < 16) { const int ii = tid & 1; float t_ = 0.f; for (int w2 = 0; w2 < 8; ++w2) t_ += red[w2 * 2 + ii]; atomicAdd(ssq_h + (tid >> 1) * XHB + ii, t_); }
            __syncthreads();
        }
    }
    { GSched<0> S; S.init(Y, WoutT, 2048, 2048, 64, 8, 1, 0, 0); EpiOut E{ssq_a, ssq_b, XN, rinvx, p.in[2], XH, ssq_h}; gemm_phase(lds, S, E); }
    xcd_barrier(xbar);

#endif
#if PH_ON(7)
#pragma unroll 1
    for (int rep = 0; rep < 1 + DUP_ON(7); ++rep)
    { { GSched<1> S; S.init(XH, WupT, 2048, 2048, 65, 43, 1, 0, 0); EpiUp E{ACT, ssq_h, p.in[23], p.in[24]}; gemm_phase(lds, S, E); }
    xcd_barrier(xbar); }

#endif
#if PH_ON(8)
    if (G == 256) { GSched<2> S; S.init(ACT, WdT, DFF, DFF, 64, 8, 1, 0, 0); EpiDownNorm E{XH, p.out, ssq_o, barw + 3584, p.in[26]}; gemm_phase(lds, S, E); }
    else { GSched<0> S; S.init(ACT, WdT, DFF, DFF, 64, 8, 1, 0, 0); EpiDown E{XH, Y, ssq_o}; gemm_phase(lds, S, E); }
    if (G != 256) xcd_barrier(xbar);

#endif
#if PH_ON(9)
    if (G != 256)
    for (int row = bid * 8 + wid; row < 16384; row += G * 8) {
        float* orow = p.out + (size_t)row * 2048; const bf16_t* hrow = Y + (size_t)row * 2048; const float rs = rsqrtf(ssq_o[row] * (1.0f / 2048.0f) + EPS);
#pragma unroll
        for (int i = 0; i < 4; ++i) { const int c = i * 512 + lane * 8; const u32x4 w = *(const u32x4*)(hrow + c);
            u32x2 lo; lo.x = w.x; lo.y = w.y; u32x2 hi; hi.x = w.z; hi.y = w.w;
            *(f32x4*)(orow + c) = unpack4(lo) * rs * *(const f32x4*)(p.in[26] + c); *(f32x4*)(orow + c + 4) = unpack4(hi) * rs * *(const f32x4*)(p.in[26] + c + 4); }
    }
#endif
}

extern "C" void kernel_launch(void* const* d_in, const int* in_sizes, int n_in, void* d_out, int out_size, void* d_ws, size_t ws_size, hipStream_t stream) {
    static int grid_blocks = 0;
    if (!grid_blocks) {
        int dev = 0, cus = 0, per_cu = 0;
        hipGetDevice(&dev);
        hipDeviceGetAttribute(&cus, hipDeviceAttributeMultiprocessorCount, dev);
        if (hipFuncSetAttribute((const void*)fwd_megakernel, hipFuncAttributeMaxDynamicSharedMemorySize, LDS_BYTES) != hipSuccess) fprintf(stderr, "hipFuncSetAttribute failed\n");
        if (hipOccupancyMaxActiveBlocksPerMultiprocessor(&per_cu, (const void*)fwd_megakernel, NTHR, LDS_BYTES) != hipSuccess || per_cu < 1) { fprintf(stderr, "occupancy query failed\n"); per_cu = 1; }
        if (per_cu > 1) per_cu = 1;
        grid_blocks = cus * per_cu;
    }
    Params p{};
    for (int i = 0; i < 27; ++i) p.in[i] = (const float*)d_in[i];
    p.out = (float*)d_out; p.ws = (unsigned char*)d_ws;
    void* args[] = {&p};
    hipError_t e = hipLaunchCooperativeKernel((const void*)fwd_megakernel, dim3(grid_blocks), dim3(NTHR), args, LDS_BYTES, stream);
    if (e != hipSuccess) fprintf(stderr, "cooperative launch failed: %s (grid %d)\n", hipGetErrorString(e), grid_blocks);
}
```

```cpp
#include <hip/hip_runtime.h>
#include <hip/hip_cooperative_groups.h>
#include <cstdio>
#include <cstdint>
namespace cg = cooperative_groups;

#define LAS __attribute__((address_space(3)))
typedef unsigned short bf16_t;
typedef short bf16x8 __attribute__((ext_vector_type(8)));
typedef float f32x4 __attribute__((ext_vector_type(4)));
typedef float f32x16 __attribute__((ext_vector_type(16)));
typedef unsigned u32x4 __attribute__((ext_vector_type(4)));
typedef unsigned u32x2 __attribute__((ext_vector_type(2)));

constexpr int NB = 8, NMETA = 16, LL = 2064, DM = 2048, ROWS = NB * LL, MPAD = 16640;
constexpr int NG = 64, DFF = 5504;
constexpr int NCH = 129, GRP = 1280, XSK = 384, XHB = 2050;
constexpr float EPS = 1e-6f;
constexpr float QSCALE = 0.07216878364870322f * 1.4426950408889634f;
constexpr int NTHR = 512;

constexpr size_t al(size_t x) { return (x + 255) & ~(size_t)255; }
constexpr size_t O_WIN = 0;
constexpr size_t O_WGLU = O_WIN + al((size_t)2048 * 2048 * 2);
constexpr size_t O_WQ = O_WGLU + al((size_t)1024 * 1024 * 2);
constexpr size_t O_WKV = O_WQ + al((size_t)1536 * 512 * 2);
constexpr size_t O_WOUT = O_WKV + al((size_t)2048 * 256 * 2);
constexpr size_t O_WUP = O_WOUT + al((size_t)2048 * 2048 * 2);
constexpr size_t O_WD = O_WUP + al((size_t)11008 * 2048 * 2);
constexpr size_t O_MST = O_WD + al((size_t)2048 * 5504 * 2);
constexpr size_t O_MIO = O_MST + al((size_t)64 * 256 * 256 * 2);
constexpr size_t O_KD = O_MIO + al((size_t)64 * 256 * 384 * 2);
constexpr size_t O_PWC = O_KD + al((size_t)64 * 16 * 256 * 4);
constexpr size_t O_PW1 = O_PWC + al((size_t)4096 * 16 * 8);
constexpr size_t O_COS = O_PW1 + al((size_t)4096 * 16 * 8);
constexpr size_t O_SIN = O_COS + al((size_t)LL * 32 * 4);
constexpr size_t O_SSQ = O_SIN + al((size_t)LL * 32 * 4);
constexpr size_t O_BAR = O_SSQ + al((size_t)7 * MPAD * 4);
constexpr size_t O_Y = O_BAR + al((size_t)4096 * 4);
constexpr size_t O_E = O_Y + al((size_t)MPAD * 2048 * 2);
constexpr size_t O_XN = O_E;
constexpr size_t O_XS = O_XN + al((size_t)MPAD * 2048 * 2);
constexpr size_t O_QA = O_XS + al((size_t)64 * GRP * XSK * 2);
constexpr size_t O_KVA = O_QA + al((size_t)MPAD * 512 * 2);
constexpr size_t O_KPE = O_KVA + al((size_t)MPAD * 256 * 2);
constexpr size_t O_Q = O_KPE + al((size_t)MPAD * 64 * 2);
constexpr size_t O_KN = O_Q + al((size_t)MPAD * 1536 * 2);
constexpr size_t O_VT = O_KN + al((size_t)MPAD * 1024 * 2);
constexpr size_t O_S = O_VT + al((size_t)(NB + 1) * 8 * 128 * 2048 * 2 + 4096);
constexpr size_t O_END1 = O_S + al((size_t)64 * GRP * 128 * 4);
constexpr size_t O_G = O_Q;
constexpr size_t O_ACT = O_E + al((size_t)(NB * XHB + 16) * 2048 * 2);
constexpr size_t O_XH = O_ACT + al((size_t)16384 * DFF * 2);
constexpr size_t O_END2 = O_XH + al((size_t)(NB * XHB + 16) * 2048 * 2);
static_assert(O_XH >= O_KN, "XH must not overlap G (= Q region), read in P5");
static_assert(O_END1 <= (size_t)536870912 && O_END2 <= (size_t)536870912, "workspace map exceeds 512 MiB");

#ifndef PH_MASK
#define PH_MASK 0x3ff
#endif
#define PH_ON(n) ((PH_MASK >> (n)) & 1)
#ifndef DUP_MASK
#define DUP_MASK 0
#endif
#define DUP_ON(n) ((DUP_MASK >> (n)) & 1)
struct Params { const float* in[27]; float* out; unsigned char* ws; };

__device__ __forceinline__ unsigned cvt_pk(float lo, float hi) { unsigned r; asm volatile("v_cvt_pk_bf16_f32 %0, %1, %2" : "=v"(r) : "v"(lo), "v"(hi)); return r; }
__device__ __forceinline__ u32x2 pack4(f32x4 v) { u32x2 r; r.x = cvt_pk(v[0], v[1]); r.y = cvt_pk(v[2], v[3]); return r; }
__device__ __forceinline__ float bf2f(unsigned short b) { return __builtin_bit_cast(float, (unsigned)b << 16); }
__device__ __forceinline__ f32x4 unpack4(u32x2 w) { f32x4 r; r[0] = __builtin_bit_cast(float, w.x << 16); r[1] = __builtin_bit_cast(float, w.x & 0xffff0000u); r[2] = __builtin_bit_cast(float, w.y << 16); r[3] = __builtin_bit_cast(float, w.y & 0xffff0000u); return r; }
__device__ __forceinline__ float wave_sum(float v) {
#pragma unroll
    for (int o = 1; o < 64; o <<= 1) v += __shfl_xor(v, o);
    return v;
}
__device__ __forceinline__ float dpp_shr1(float v) { return __builtin_bit_cast(float, __builtin_amdgcn_update_dpp(0, __builtin_bit_cast(int, v), 0x111, 0xf, 0xf, true)); }
__device__ __forceinline__ float dpp_shr2(float v) { return __builtin_bit_cast(float, __builtin_amdgcn_update_dpp(0, __builtin_bit_cast(int, v), 0x112, 0xf, 0xf, true)); }
__device__ __forceinline__ float dot4(u32x2 a, u32x2 k) {
    return __builtin_bit_cast(float, a.x << 16) * __builtin_bit_cast(float, k.x << 16) + __builtin_bit_cast(float, a.x & 0xffff0000u) * __builtin_bit_cast(float, k.x & 0xffff0000u)
         + __builtin_bit_cast(float, a.y << 16) * __builtin_bit_cast(float, k.y << 16) + __builtin_bit_cast(float, a.y & 0xffff0000u) * __builtin_bit_cast(float, k.y & 0xffff0000u);
}
__device__ __forceinline__ bf16_t f2bf(float v) { return (bf16_t)(cvt_pk(v, 0.f) & 0xffff); }
__device__ __forceinline__ float fexp2(float x) { return __builtin_amdgcn_exp2f(x); }
__device__ __forceinline__ float sigmoidf_(float x) { return __builtin_amdgcn_rcpf(1.0f + __builtin_amdgcn_exp2f(-1.4426950408889634f * x)); }

constexpr int BM = 256, BK = 64, HALF = 128, HTB = HALF * BK * 2, STAGE_BYTES = 8 * HTB;
constexpr int EPF_OFF = STAGE_BYTES + 16384 + 64, EPF_WAVE = 1536;
constexpr int LDS_BYTES = EPF_OFF + 8 * EPF_WAVE;
static_assert(LDS_BYTES <= 163840, "LDS");

__device__ __forceinline__ int lds_byte(int r, int c) { const int st = (r >> 4) * 2 + (c >> 5), rr = r & 15, cc = c & 31, ob = rr * 64 + cc * 2; return st * 1024 + (ob ^ (((ob >> 9) & 1) << 5)); }
__device__ __forceinline__ void stage_rc(int b, int& R, int& C) { const int st = b / 1024, sb = b % 1024, swz = sb ^ (((sb >> 9) & 1) << 5); R = (st >> 1) * 16 + swz / 64; C = (st & 1) * 32 + (swz % 64) / 2; }

struct Unit { int pm, pn, bt; };

template <int MODE>
struct GSched {
    const char* A; const char* Bt; int lda, K; size_t strideA, strideB; int nM, nN, nB, G, c; long nwg;
    __device__ __forceinline__ void init(const void* A_, const void* Bt_, int lda_, int K_, int nM_, int nN_, int nB_, size_t sA, size_t sB) {
        A = (const char*)A_; Bt = (const char*)Bt_; lda = lda_; K = K_; nM = nM_; nN = nN_; nB = nB_; strideA = sA; strideB = sB; G = gridDim.x; c = blockIdx.x; nwg = (long)nM * nN * nB;
    }
    __device__ __forceinline__ bool next(int i, Unit& u) const {
        if (MODE == 2) { if (i >= 2) return false; const int x = c & 7, y = c >> 3; u.pm = 32 * i + 4 * x + (y >> 3); u.pn = y & 7; u.bt = 0; return true; }
        const long L = (long)i * G + c; if (L >= nwg) return false;
        const int per = nM * nN; const int bt = (int)(L / per); int w = (int)(L - (long)bt * per);
        if (nB == 1) { const int q = per / 8, r = per % 8, xcd = w % 8, off = w / 8; w = (xcd < r ? xcd * (q + 1) : r * (q + 1) + (xcd - r) * q) + off; }
        const int nig = 8 * nN, gid = w / nig, fm = gid * 8, gsz = (nM - fm) < 8 ? (nM - fm) : 8;
        u.pm = fm + ((w % nig) % gsz); u.pn = (w % nig) / gsz; u.bt = bt; return true;
    }
    __device__ __forceinline__ const char* a_base(const Unit& u) const {
        if (MODE == 1) { if (u.pm == 64) return A; return A + (size_t)((u.pm >> 3) * XHB + (u.pm & 7) * 256) * lda * 2; }
        return A + (size_t)u.bt * strideA + (size_t)u.pm * 256 * lda * 2;
    }
    __device__ __forceinline__ size_t a_hstep(const Unit& u) const { if (MODE == 1 && u.pm == 64) return (size_t)4 * XHB * lda * 2; return (size_t)HALF * lda * 2; }
    __device__ __forceinline__ unsigned a_voff(const Unit& u, int R, int C) const {
        if (MODE == 1 && u.pm == 64) return (unsigned)(((R >> 5) * XHB + ((R >> 2) & 7) * 256 + 254 + (R & 3)) * lda + C) * 2u;
        return (unsigned)(R * lda + C) * 2u;
    }
    __device__ __forceinline__ const char* b_base(const Unit& u) const { return Bt + (size_t)u.bt * strideB + (size_t)u.pn * 256 * K * 2; }
};

template <class Epi, class Sched>
__device__ __forceinline__ void gemm_phase(LAS unsigned char* lds, const Sched& S, const Epi& E) {
    int tid = threadIdx.x; asm volatile("" : "+v"(tid));
    const int wid = __builtin_amdgcn_readfirstlane(tid >> 6), lane = tid & 63, wr = wid >> 2, wc = wid & 3, fr = lane & 15, fq = lane >> 4;
    const int K = S.K, nt = K / BK;
    int sR[2], sC[2]; unsigned voffB[2];
#pragma unroll
    for (int i = 0; i < 2; ++i) { stage_rc(tid * 16 + i * 8192, sR[i], sC[i]); voffB[i] = (unsigned)(sR[i] * K + sC[i]) * 2u; }
    const size_t kstep = (size_t)(BK * 2), hstepB = (size_t)HALF * K * 2;
    const unsigned ldsw = (unsigned)wid * 1024u;
    const int aoff = lds_byte(wr * 64 + fr, fq * 8), boff = lds_byte(wc * 32 + fr, fq * 8);
#define G_SA(b, h) (((b) * 2 + (h)) * HTB)
#define G_SB(b, h) ((4 + (b) * 2 + (h)) * HTB)
#define G_STAGE(bufoff, gbase, v0, v1) do { \
        __builtin_amdgcn_global_load_lds((const unsigned*)((const char*)(gbase) + (v0)), (LAS unsigned*)(lds + (bufoff) + ldsw), 16, 0, 0); \
        __builtin_amdgcn_global_load_lds((const unsigned*)((const char*)(gbase) + (v1)), (LAS unsigned*)(lds + (bufoff) + ldsw + 8192), 16, 0, 0); } while (0)
#define G_LDA(dst, b, h) do { _Pragma("unroll") for (int m = 0; m < 4; ++m) _Pragma("unroll") for (int k = 0; k < 2; ++k) dst[m][k] = *(const LAS bf16x8*)(lds + G_SA(b, h) + aoff + m * 2048 + k * 1024); } while (0)
#define G_LDB(dst, b, h) do { _Pragma("unroll") for (int n = 0; n < 2; ++n) _Pragma("unroll") for (int k = 0; k < 2; ++k) dst[n][k] = *(const LAS bf16x8*)(lds + G_SB(b, h) + boff + n * 2048 + k * 1024); } while (0)
#define G_MMA(ai, bj, At, Bt) do { __builtin_amdgcn_s_setprio(1); _Pragma("unroll") for (int m = 0; m < 4; ++m) _Pragma("unroll") for (int n = 0; n < 2; ++n) _Pragma("unroll") for (int k = 0; k < 2; ++k) \
        acc[ai][bj][m][n] = __builtin_amdgcn_mfma_f32_16x16x32_bf16(Bt[n][k], At[m][k], acc[ai][bj][m][n], 0, 0, 0); __builtin_amdgcn_s_setprio(0); } while (0)
#define G_WAIT_V(n) asm volatile("s_waitcnt vmcnt(" #n ")" ::: "memory")
#define G_WAIT_L(n) asm volatile("s_waitcnt lgkmcnt(" #n ")" ::: "memory")
#define G_BAR __builtin_amdgcn_s_barrier()
#define G_SCHED __builtin_amdgcn_sched_barrier(0)
    Unit cur, nxt; int ui = 0;
    if (!S.next(0, cur)) return;
    f32x4 acc[2][2][4][2];
#pragma unroll
    for (int a = 0; a < 2; ++a)
#pragma unroll
        for (int b = 0; b < 2; ++b)
#pragma unroll
            for (int m = 0; m < 4; ++m)
#pragma unroll
                for (int n = 0; n < 2; ++n) acc[a][b][m][n] = (f32x4){0.f, 0.f, 0.f, 0.f};
    bf16x8 At[4][2], B0[2][2], B1[2][2];
    const char* cA = S.a_base(cur); const char* cB = S.b_base(cur);
    unsigned vc0 = S.a_voff(cur, sR[0], sC[0]), vc1 = S.a_voff(cur, sR[1], sC[1]); size_t hAc = S.a_hstep(cur);
    const unsigned vb0 = voffB[0], vb1 = voffB[1];
    if constexpr (Epi::PREFETCH) E.prefetch(cur, wr, wc, lane, lds + EPF_OFF + wid * EPF_WAVE);
    G_STAGE(G_SB(0, 0), cB, vb0, vb1); G_STAGE(G_SB(0, 1), cB + hstepB, vb0, vb1); G_STAGE(G_SA(0, 0), cA, vc0, vc1); G_STAGE(G_SA(0, 1), cA + hAc, vc0, vc1);
    if (wr == 1) G_BAR;
    G_WAIT_V(2); G_BAR;
    G_STAGE(G_SB(1, 0), cB + kstep, vb0, vb1); G_STAGE(G_SA(1, 0), cA + kstep, vc0, vc1); G_STAGE(G_SB(1, 1), cB + hstepB + kstep, vb0, vb1);
    G_WAIT_V(6); G_BAR;
    for (;;) {
        const bool has_next = S.next(ui + 1, nxt);
        const char* nA = has_next ? S.a_base(nxt) : cA; const char* nB = has_next ? S.b_base(nxt) : cB;
        const unsigned vn0 = has_next ? S.a_voff(nxt, sR[0], sC[0]) : vc0, vn1 = has_next ? S.a_voff(nxt, sR[1], sC[1]) : vc1; const size_t hAn = has_next ? S.a_hstep(nxt) : hAc;
        for (int t = 0; t < nt; t += 2) {
            const bool last = (t == nt - 2);
            if constexpr (Epi::MIDSCALE) { if (t == nt / 2) { int e_fr = fr, e_wr = wr; asm volatile("" : "+v"(e_fr)); asm volatile("" : "+s"(e_wr)); E.mid(acc, cur, e_wr, e_fr); } }
            const char* a1 = cA + (size_t)(t + 1) * kstep;
            const char* a2 = last ? nA : cA + (size_t)(t + 2) * kstep; const char* b2 = last ? nB : cB + (size_t)(t + 2) * kstep;
            const char* a3 = a2 + kstep; const char* b3 = b2 + kstep;
            const unsigned v20 = last ? vn0 : vc0, v21 = last ? vn1 : vc1; const size_t h2 = last ? hAn : hAc;
            G_LDB(B0, 0, 0); G_LDB(B1, 0, 1); G_SCHED; G_LDA(At, 0, 0); G_STAGE(G_SA(1, 1), a1 + hAc, vc0, vc1);
            G_WAIT_V(8); G_WAIT_L(0); G_BAR; G_MMA(0, 0, At, B0); G_MMA(0, 1, At, B1); G_BAR; G_SCHED;
            G_LDA(At, 0, 1); G_STAGE(G_SB(0, 0), b2, vb0, vb1); G_STAGE(G_SB(0, 1), b2 + hstepB, vb0, vb1); G_STAGE(G_SA(0, 0), a2, v20, v21);
            G_WAIT_V(8); G_WAIT_L(0); G_BAR; G_MMA(1, 0, At, B0); G_MMA(1, 1, At, B1); G_BAR; G_SCHED;
            G_LDB(B0, 1, 0); G_LDB(B1, 1, 1); G_SCHED; G_LDA(At, 1, 0); G_STAGE(G_SA(0, 1), a2 + h2, v20, v21);
            G_WAIT_V(8); G_WAIT_L(0); G_BAR; G_MMA(0, 0, At, B0); G_MMA(0, 1, At, B1); G_BAR; G_SCHED;
            G_LDA(At, 1, 1); G_STAGE(G_SB(1, 0), b3, vb0, vb1); G_STAGE(G_SB(1, 1), b3 + hstepB, vb0, vb1); G_STAGE(G_SA(1, 0), a3, v20, v21);
            G_WAIT_V(8); G_WAIT_L(0); G_BAR; G_MMA(1, 0, At, B0); G_MMA(1, 1, At, B1); G_BAR; G_SCHED;
        }
        if (wr == 0) G_BAR;
        { int e_fr = fr, e_fq = fq, e_wr = wr, e_wc = wc; asm volatile("" : "+v"(e_fr), "+v"(e_fq)); asm volatile("" : "+s"(e_wr), "+s"(e_wc));
          E(acc, cur, e_wr, e_wc, e_fr, e_fq, lds + STAGE_BYTES);
          if constexpr (Epi::PREFETCH) { if (has_next) { int e_lane = lane; asm volatile("" : "+v"(e_lane)); E.prefetch(nxt, e_wr, e_wc, e_lane, lds + EPF_OFF + wid * EPF_WAVE); } } }
        if (!has_next) break;
#pragma unroll
        for (int a = 0; a < 2; ++a)
#pragma unroll
            for (int b = 0; b < 2; ++b)
#pragma unroll
                for (int m = 0; m < 4; ++m)
#pragma unroll
                    for (int n = 0; n < 2; ++n) acc[a][b][m][n] = (f32x4){0.f, 0.f, 0.f, 0.f};
        cur = nxt; cA = nA; cB = nB; vc0 = vn0; vc1 = vn1; hAc = hAn; ++ui;
        if (wr == 1) G_BAR;
    }
    G_WAIT_V(0);
    G_BAR;
}

#define EPI_ARGS f32x4 (&acc)[2][2][4][2], const Unit& u, int wr, int wc, int fr, int fq, LAS unsigned char* xl
#define FOR_AI_M _Pragma("unroll") for (int ai = 0; ai < 2; ++ai) _Pragma("unroll") for (int m = 0; m < 4; ++m)
#define FOR_BJ_N _Pragma("unroll") for (int bj = 0; bj < 2; ++bj) _Pragma("unroll") for (int n = 0; n < 2; ++n)

struct EpiZ {
    static constexpr bool MIDSCALE = false, PREFETCH = false;
    bf16_t* XS; bf16_t* QA; bf16_t* KVA; bf16_t* KPE; float* ssq_q; float* ssq_kv; const float* cs; const float* sn;
    __device__ __forceinline__ void operator()(EPI_ARGS) const {
        const int pn = u.pn;
        FOR_AI_M {
            const int row = u.pm * 256 + ai * 128 + wr * 64 + m * 16 + fr;
            if (pn < 4) {
                FOR_BJ_N { const int g = 16 * pn + 8 * bj + 2 * wc + n;
                    *(u32x2*)(XS + ((size_t)(g * GRP + (row >> 4)) * XSK + (row & 15) * 16 + 4 * fq)) = pack4(acc[ai][bj][m][n]); }
            } else if (pn < 7) {
                float ss = 0.f;
                FOR_BJ_N { const f32x4 v = acc[ai][bj][m][n]; ss += v[0] * v[0] + v[1] * v[1] + v[2] * v[2] + v[3] * v[3];
                    const int col = bj * 128 + wc * 32 + n * 16 + 4 * fq;
                    if (pn < 6) *(u32x2*)(QA + ((size_t)row * 512 + (pn - 4) * 256 + col)) = pack4(v);
                    else *(u32x2*)(KVA + ((size_t)row * 256 + col)) = pack4(v); }
                ss += __shfl_xor(ss, 16); ss += __shfl_xor(ss, 32);
                if (fq == 0 && ssq_q) atomicAdd((pn < 6 ? ssq_q : ssq_kv) + row, ss);
            } else {
                if (wc < 2) {
                    const int t = (row & 2047) + 16; const f32x4 x1 = acc[ai][0][m][0], x2 = acc[ai][0][m][1]; f32x4 y1, y2;
                    const f32x4 c = *(const f32x4*)(cs + t * 32 + wc * 16 + 4 * fq), s = *(const f32x4*)(sn + t * 32 + wc * 16 + 4 * fq);
#pragma unroll
                    for (int e = 0; e < 4; ++e) { y1[e] = x1[e] * c[e] - x2[e] * s[e]; y2[e] = x2[e] * c[e] + x1[e] * s[e]; }
                    *(u32x2*)(KPE + ((size_t)row * 64 + wc * 32 + 4 * fq)) = pack4(y1);
                    *(u32x2*)(KPE + ((size_t)row * 64 + wc * 32 + 16 + 4 * fq)) = pack4(y2);
                }
            }
        }
    }
};

struct EpiQ {
    static constexpr bool MIDSCALE = false, PREFETCH = false;
    bf16_t* Q; const float* ssq_q; const float* cs; const float* sn;
    __device__ __forceinline__ void operator()(EPI_ARGS) const {
        FOR_AI_M {
            const int row = u.pm * 256 + ai * 128 + wr * 64 + m * 16 + fr;
            const float rs = rsqrtf(ssq_q[row] * (1.0f / 512.0f) + EPS) * QSCALE;
            const int t = (row & 2047) + 16;
#pragma unroll
            for (int bj = 0; bj < 2; ++bj) {
                const int cb = u.pn * 256 + bj * 128 + wc * 32;
                f32x4 v0 = acc[ai][bj][m][0] * rs, v1 = acc[ai][bj][m][1] * rs;
                if (((cb >> 6) % 3) == 2) {
                    const int j = (wc & 1) * 16 + 4 * fq;
                    const f32x4 c = *(const f32x4*)(cs + t * 32 + j), s = *(const f32x4*)(sn + t * 32 + j); f32x4 y1, y2;
#pragma unroll
                    for (int e = 0; e < 4; ++e) { y1[e] = v0[e] * c[e] - v1[e] * s[e]; y2[e] = v1[e] * c[e] + v0[e] * s[e]; }
                    v0 = y1; v1 = y2;
                }
                *(u32x2*)(Q + ((size_t)row * 1536 + cb + 4 * fq)) = pack4(v0);
                *(u32x2*)(Q + ((size_t)row * 1536 + cb + 16 + 4 * fq)) = pack4(v1);
            }
        }
    }
};

struct EpiKV {
    static constexpr bool MIDSCALE = false, PREFETCH = false;
    bf16_t* KN; bf16_t* VT; const float* ssq_kv;
    __device__ __forceinline__ void operator()(EPI_ARGS) const {
        FOR_AI_M {
            const int row = u.pm * 256 + ai * 128 + wr * 64 + m * 16 + fr;
            {
                const float rs = rsqrtf(ssq_kv[row] * (1.0f / 256.0f) + EPS);
                const int b = row >> 11, t = row & 2047;
#pragma unroll
                for (int n = 0; n < 2; ++n) {
                    *(u32x2*)(KN + ((size_t)row * 1024 + u.pn * 128 + wc * 32 + n * 16 + 4 * fq)) = pack4(acc[ai][0][m][n] * rs);
                    const f32x4 v = acc[ai][1][m][n] * rs; const int d = wc * 32 + n * 16 + 4 * fq;
                    bf16_t* vp = VT + ((size_t)((b * 8 + u.pn) * 128 + d)) * 2048 + t;
                    const unsigned w0 = cvt_pk(v[0], v[1]), w1 = cvt_pk(v[2], v[3]);
                    vp[0] = (bf16_t)(w0 & 0xffff); vp[2048] = (bf16_t)(w0 >> 16); vp[2 * 2048] = (bf16_t)(w1 & 0xffff); vp[3 * 2048] = (bf16_t)(w1 >> 16);
                }
            }
        }
    }
};

struct EpiS {
    static constexpr bool MIDSCALE = false, PREFETCH = false;
    float* S;
    __device__ __forceinline__ void operator()(EPI_ARGS) const {
        FOR_AI_M {
            const int R = u.pm * 256 + ai * 128 + wr * 64 + m * 16 + fr;
#pragma unroll
            for (int n = 0; n < 2; ++n) *(f32x4*)(S + ((size_t)(u.bt * GRP + R) * 128 + wc * 32 + n * 16 + 4 * fq)) = acc[ai][0][m][n];
        }
    }
};

struct EpiY {
    static constexpr bool MIDSCALE = false, PREFETCH = false;
    const bf16_t* XS; bf16_t* G; const float* dskip;
    __device__ __forceinline__ void operator()(EPI_ARGS) const {
        const int g = u.bt;
        const f32x4 dk = *(const f32x4*)(dskip + g * 16 + 4 * fq);
        FOR_AI_M {
            const int R = u.pm * 256 + ai * 128 + wr * 64 + m * 16 + fr;
            {
                FOR_BJ_N { const int col = bj * 128 + wc * 32 + n * 16 + 4 * fq; const int t = col >> 4;
                    const int grow = R * 16 + t;
                    const f32x4 uu = unpack4(*(const u32x2*)(XS + ((size_t)(g * GRP + R) * XSK + col)));
                    f32x4 y = acc[ai][bj][m][n] + dk * uu, o;
#pragma unroll
                    for (int e = 0; e < 4; ++e) { const float a = y[e]; o[e] = a * sigmoidf_(1.5957691216f * (a + 0.044715f * a * a * a)); }
                    *(u32x2*)(G + ((size_t)grow * 1024 + g * 16 + 4 * fq)) = pack4(o); }
            }
        }
    }
};

struct EpiGlu {
    static constexpr bool MIDSCALE = false, PREFETCH = false;
    const bf16_t* G; bf16_t* Y; const float* bglu; float* ssq_a;
    __device__ __forceinline__ void operator()(EPI_ARGS) const {
        FOR_AI_M {
            const int row = u.pm * 256 + ai * 128 + wr * 64 + m * 16 + fr; float ss = 0.f;
            FOR_BJ_N { const int col = u.pn * 256 + bj * 128 + wc * 32 + n * 16 + 4 * fq;
                const f32x4 gg = unpack4(*(const u32x2*)(G + ((size_t)row * 1024 + col))); const f32x4 bb = *(const f32x4*)(bglu + col); f32x4 o;
#pragma unroll
                for (int e = 0; e < 4; ++e) { o[e] = gg[e] * sigmoidf_(acc[ai][bj][m][n][e] + bb[e]); ss += o[e] * o[e]; }
                *(u32x2*)(Y + ((size_t)row * 2048 + col)) = pack4(o); }
            ss += __shfl_xor(ss, 16); ss += __shfl_xor(ss, 32);
            if (fq == 0) atomicAdd(ssq_a + row, ss);
        }
    }
};

struct EpiOut {
    static constexpr bool MIDSCALE = true, PREFETCH = false;
    const float* ssq_a; const float* ssq_b; const bf16_t* XN; const float* rinvx; const float* gmix; bf16_t* XH; float* ssq_h;
    __device__ __forceinline__ void mid(f32x4 (&acc)[2][2][4][2], const Unit& u, int wr, int fr) const {
        FOR_AI_M {
            const int row = u.pm * 256 + ai * 128 + wr * 64 + m * 16 + fr;
            const float ra = rsqrtf(ssq_a[row] * (1.0f / 1024.0f) + EPS), rb = rsqrtf(ssq_b[row] * (1.0f / 1024.0f) + EPS); const float r = ra / rb;
            FOR_BJ_N acc[ai][bj][m][n] *= r;
        }
    }
    __device__ __forceinline__ void operator()(EPI_ARGS) const {
        f32x4 ginv[2][2];
        FOR_BJ_N { const f32x4 gg = *(const f32x4*)(gmix + u.pn * 256 + bj * 128 + wc * 32 + n * 16 + 4 * fq);
#pragma unroll
            for (int e = 0; e < 4; ++e) ginv[bj][n][e] = __builtin_amdgcn_rcpf(gg[e]); }
        FOR_AI_M {
            const int row = u.pm * 256 + ai * 128 + wr * 64 + m * 16 + fr;
            const float rb = rsqrtf(ssq_b[row] * (1.0f / 1024.0f) + EPS), ri = rinvx[row];
            const int b = row >> 11, tp = row & 2047;
            const bf16_t* hrow = XN + (size_t)row * 2048;
            float ss = 0.f;
            FOR_BJ_N { const int col = u.pn * 256 + bj * 128 + wc * 32 + n * 16 + 4 * fq;
                const f32x4 v = acc[ai][bj][m][n] * rb + unpack4(*(const u32x2*)(hrow + col)) * (ginv[bj][n] * ri);
                ss += v[0] * v[0] + v[1] * v[1] + v[2] * v[2] + v[3] * v[3];
                *(u32x2*)(XH + ((size_t)(b * XHB + tp + 2) * 2048 + col)) = pack4(v); }
            ss += __shfl_xor(ss, 16); ss += __shfl_xor(ss, 32);
            if (fq == 0) atomicAdd(ssq_h + b * XHB + tp + 2, ss);
        }
    }
};

struct EpiUp {
    static constexpr bool MIDSCALE = false, PREFETCH = true;
    bf16_t* ACT; const float* ssq_h; const float* cw; const float* cb;
    __device__ __forceinline__ void prefetch(const Unit& u, int wr, int wc, int lane, LAS unsigned char* pf) const {
        const bool gather = (u.pm == 64);
#pragma unroll
        for (int ai = 0; ai < 2; ++ai) {
            const int R = ai * 128 + wr * 64 + lane;
            const int xrow = gather ? ((R >> 5) * XHB + ((R >> 2) & 7) * 256 + 254 + (R & 3)) : ((u.pm >> 3) * XHB + (u.pm & 7) * 256 + R);
            __builtin_amdgcn_global_load_lds((const unsigned*)(ssq_h + xrow), (LAS unsigned*)(pf + ai * 256), 4, 0, 0);
        }
        const int l5 = lane & 31, a = l5 >> 3, piece = l5 & 7;
        const float* src = (a < 3 ? cw + a * DFF : cb) + u.pn * 128 + wc * 32 + piece * 4;
        __builtin_amdgcn_global_load_lds((const unsigned*)src, (LAS unsigned*)(pf + 512), 16, 0, 0);
    }
    __device__ __forceinline__ void operator()(EPI_ARGS) const {
        LAS float* halo = (LAS float*)xl;
        const bool gather = (u.pm == 64);
        const LAS float* pf = (const LAS float*)(xl + (EPF_OFF - STAGE_BYTES) + (wr * 4 + wc) * EPF_WAVE);
        float rsv[2][4];
        FOR_AI_M { rsv[ai][m] = pf[ai * 64 + m * 16 + fr]; }
        f32x4 W0[2], W1[2], W2[2], BB[2];
#pragma unroll
        for (int n = 0; n < 2; ++n) { const int c8 = 8 * fq + 4 * n;
            W0[n] = *(const LAS f32x4*)(pf + 128 + c8); W1[n] = *(const LAS f32x4*)(pf + 128 + 32 + c8); W2[n] = *(const LAS f32x4*)(pf + 128 + 64 + c8); BB[n] = *(const LAS f32x4*)(pf + 128 + 96 + c8); }
        FOR_AI_M {
            const float rs = rsqrtf(rsv[ai][m] * (1.0f / 2048.0f) + EPS);
            FOR_BJ_N acc[ai][bj][m][n] *= rs;
            if (fr >= 14) {
                const int rb = ai * 8 + wr * 4 + m;
#pragma unroll
                for (int n = 0; n < 2; ++n) *(LAS f32x4*)(halo + ((rb * 2 + (fr - 14)) * 128 + wc * 32 + 8 * fq + 4 * n)) = acc[ai][0][m][n];
            }
        }
        asm volatile("s_waitcnt lgkmcnt(0)" ::: "memory"); __builtin_amdgcn_s_barrier(); asm volatile("" ::: "memory");
        FOR_AI_M {
            const int R = ai * 128 + wr * 64 + m * 16 + fr; const int rb = ai * 8 + wr * 4 + m;
            u32x4 ow;
            const bool valid = gather ? ((R & 3) >= 2) : (R >= 2);
            const int orow = gather ? (256 * (R >> 2) + 252 + (R & 3)) : (256 * u.pm + R - 2);
#pragma unroll
            for (int n = 0; n < 2; ++n) {
                const int cl = wc * 32 + 8 * fq + 4 * n;
                f32x4 hA = (f32x4){0.f, 0.f, 0.f, 0.f}, hB = (f32x4){0.f, 0.f, 0.f, 0.f};
                if (fr < 2 && rb > 0) { hA = *(const LAS f32x4*)(halo + (((rb - 1) * 2 + fr) * 128 + cl)); if (fr == 0) hB = *(const LAS f32x4*)(halo + (((rb - 1) * 2 + 1) * 128 + cl)); }
                const f32x4 g0 = acc[ai][0][m][n], vv = acc[ai][1][m][n];
                f32x4 d1, d2;
#pragma unroll
                for (int e = 0; e < 4; ++e) { d1[e] = dpp_shr1(g0[e]); d2[e] = dpp_shr2(g0[e]); }
                const f32x4 g1 = d1 + hB, g2 = d2 + hA;
                const f32x4 cv = W0[n] * g2 + (W1[n] * g1 + (W2[n] * g0 + BB[n]));
                const f32x4 tt = cv * -1.4426950408889634f; f32x4 den;
#pragma unroll
                for (int e = 0; e < 4; ++e) den[e] = __builtin_amdgcn_exp2f(tt[e]);
                den = den + 1.0f; f32x4 rc;
#pragma unroll
                for (int e = 0; e < 4; ++e) rc[e] = __builtin_amdgcn_rcpf(den[e]);
                const f32x4 o = (cv * rc) * vv;
                const u32x2 pk = pack4(o); if (n == 0) { ow.x = pk.x; ow.y = pk.y; } else { ow.z = pk.x; ow.w = pk.y; }
            }
            if (valid) *(u32x4*)(ACT + ((size_t)orow * DFF + u.pn * 128 + wc * 32 + 8 * fq)) = ow;
        }
    }
};

struct EpiDown {
    static constexpr bool MIDSCALE = false, PREFETCH = false;
    const bf16_t* XH; bf16_t* H2; float* ssq_o;
    __device__ __forceinline__ void operator()(EPI_ARGS) const {
        FOR_AI_M {
            const int row = u.pm * 256 + ai * 128 + wr * 64 + m * 16 + fr; float ss = 0.f;
            const bf16_t* hrow = XH + (size_t)((row >> 11) * XHB + (row & 2047) + 2) * 2048;
            FOR_BJ_N { const int col = u.pn * 256 + bj * 128 + wc * 32 + n * 16 + 4 * fq;
                const f32x4 v = unpack4(*(const u32x2*)(hrow + col)) + acc[ai][bj][m][n];
                ss += v[0] * v[0] + v[1] * v[1] + v[2] * v[2] + v[3] * v[3]; *(u32x2*)(H2 + ((size_t)row * 2048 + col)) = pack4(v); }
            ss += __shfl_xor(ss, 16); ss += __shfl_xor(ss, 32);
            if (fq == 0) atomicAdd(ssq_o + row, ss);
        }
    }
};

struct EpiDownNorm {
    static constexpr bool MIDSCALE = false, PREFETCH = false;
    const bf16_t* XH; float* out; float* ssq_o; unsigned* cnt; const float* gain;
    __device__ __forceinline__ void operator()(EPI_ARGS) const {
        FOR_AI_M {
            const int row = u.pm * 256 + ai * 128 + wr * 64 + m * 16 + fr; float ss = 0.f;
            const bf16_t* hrow = XH + (size_t)((row >> 11) * XHB + (row & 2047) + 2) * 2048;
            FOR_BJ_N { const int col = u.pn * 256 + bj * 128 + wc * 32 + n * 16 + 4 * fq;
                const f32x4 v = unpack4(*(const u32x2*)(hrow + col)) + acc[ai][bj][m][n]; acc[ai][bj][m][n] = v;
                ss += v[0] * v[0] + v[1] * v[1] + v[2] * v[2] + v[3] * v[3]; }
            ss += __shfl_xor(ss, 16); ss += __shfl_xor(ss, 32);
            if (fq == 0) __hip_atomic_fetch_add(ssq_o + row, ss, __ATOMIC_RELAXED, __HIP_MEMORY_SCOPE_AGENT);
        }
        asm volatile("s_waitcnt vmcnt(0)" ::: "memory"); __builtin_amdgcn_s_barrier(); asm volatile("" ::: "memory");
        if (threadIdx.x == 0) {
            __builtin_amdgcn_fence(__ATOMIC_RELEASE, "agent");
            __hip_atomic_fetch_add(cnt + u.pm, 1u, __ATOMIC_RELAXED, __HIP_MEMORY_SCOPE_AGENT);
            unsigned sp = 0;
            while (__hip_atomic_load(cnt + u.pm, __ATOMIC_RELAXED, __HIP_MEMORY_SCOPE_AGENT) < 8u) { __builtin_amdgcn_s_sleep(1); if (++sp > (1u << 22)) break; }
            __builtin_amdgcn_fence(__ATOMIC_ACQUIRE, "agent");
            asm volatile("s_waitcnt vmcnt(0)" ::: "memory");
        }
        __builtin_amdgcn_s_barrier(); asm volatile("" ::: "memory");
        f32x4 gv[2][2];
#pragma unroll
        for (int bj = 0; bj < 2; ++bj)
#pragma unroll
            for (int n = 0; n < 2; ++n) gv[bj][n] = *(const f32x4*)(gain + u.pn * 256 + bj * 128 + wc * 32 + n * 16 + 4 * fq);
        FOR_AI_M {
            const int row = u.pm * 256 + ai * 128 + wr * 64 + m * 16 + fr;
            const float rs = rsqrtf(__hip_atomic_load(ssq_o + row, __ATOMIC_RELAXED, __HIP_MEMORY_SCOPE_AGENT) * (1.0f / 2048.0f) + EPS);
            FOR_BJ_N { const int col = u.pn * 256 + bj * 128 + wc * 32 + n * 16 + 4 * fq;
                __builtin_nontemporal_store(acc[ai][bj][m][n] * rs * gv[bj][n], (f32x4*)(out + ((size_t)row * 2048 + col))); }
        }
    }
};

__device__ __forceinline__ int sigma64(int p) { return (p >> 5) * 16 + (p & 15) + 32 * ((p >> 4) & 1); }

template <int WID>
__device__ __forceinline__ void transpose_tile(const Params& p, bf16_t* Wt, int K, int ldw, const float* W, int nt_, int kt_, LAS float* scr, int tid) {
    const int n0 = nt_ * 64, k0 = kt_ * 128;
    {
        const int c4 = (tid & 15) * 4; const int np = n0 + c4; int sc;
        if (WID == 0) { sc = np < 1792 ? np : (np < 1856 ? 1792 + sigma64(np - 1792) : -1); }
        else if (WID == 2) { const int h = np / 192, d = np - h * 192; sc = d < 128 ? np : h * 192 + 128 + sigma64(d - 128); }
        else if (WID == 5) { const int i32 = np & 31; const int jj = (np & 96) + 8 * ((i32 >> 2) & 3) + 4 * (i32 >> 4) + (i32 & 3); sc = ((np >> 7) & 1) * DFF + (np >> 8) * 128 + jj; }
        else sc = np;
        f32x4 v[4];
#pragma unroll
        for (int i = 0; i < 4; ++i) { const int kk = (tid >> 4) + 32 * i; v[i] = sc >= 0 ? __builtin_nontemporal_load((const f32x4*)(W + (size_t)(k0 + kk) * ldw + sc)) : (f32x4){0.f, 0.f, 0.f, 0.f}; }
#pragma unroll
        for (int i = 0; i < 4; ++i) {
            const int kk = (tid >> 4) + 32 * i; const int k = k0 + kk; float ksc = 1.0f;
            if (WID == 2) ksc = p.in[14][k];
            if (WID == 3) ksc = p.in[16][k];
            if (WID == 4) ksc = (k < 1024 ? p.in[18][k] : p.in[19][k - 1024]);
            if (WID == 5) ksc = p.in[21][k];
#pragma unroll
            for (int e = 0; e < 4; ++e) scr[kk * 65 + c4 + e] = v[i][e] * ksc;
        }
    }
    __syncthreads();
#pragma unroll
    for (int j = 0; j < 2; ++j) {
        const int idx = tid + 512 * j; const int r = idx >> 4, kg = (idx & 15) * 8; u32x4 w;
        w.x = cvt_pk(scr[(kg + 0) * 65 + r], scr[(kg + 1) * 65 + r]); w.y = cvt_pk(scr[(kg + 2) * 65 + r], scr[(kg + 3) * 65 + r]);
        w.z = cvt_pk(scr[(kg + 4) * 65 + r], scr[(kg + 5) * 65 + r]); w.w = cvt_pk(scr[(kg + 6) * 65 + r], scr[(kg + 7) * 65 + r]);
        *(u32x4*)(Wt + ((size_t)(n0 + r) * K + k0 + kg)) = w;
    }
    __syncthreads();
}

constexpr int KS_BYTES = 64 * 384, VS_BYTES = 128 * 128, KV_BYTES = KS_BYTES + VS_BYTES;
__device__ __forceinline__ int pi32(int r) { return (r & 0x13) | ((r & 4) << 1) | ((r & 8) >> 1); }

__device__ __forceinline__ void attn_unit(LAS unsigned char* lds, const bf16_t* Q, const bf16_t* KN, const bf16_t* KPE, const bf16_t* VT, bf16_t* Y, float* ssq_b, int b, int h, int qg) {
    const int tid = threadIdx.x, wid = __builtin_amdgcn_readfirstlane(tid >> 6), lane = tid & 63, q = lane & 31, hh = lane >> 5;
    const int t0 = 16 + 256 * qg, c0 = 1 + 4 * qg, cw = c0 + (wid >> 1), ntiles = c0 + 4;
    bf16x8 qf[12];
    {
        const bf16_t* qp = Q + (size_t)(b * 2048 + (t0 - 16) + 32 * wid + q) * 1536 + h * 192 + 8 * hh;
#pragma unroll
        for (int ks = 0; ks < 12; ++ks) qf[ks] = *(const bf16x8*)(qp + 16 * ks);
    }
    f32x16 o[4];
#pragma unroll
    for (int d = 0; d < 4; ++d)
#pragma unroll
        for (int i = 0; i < 16; ++i) o[d][i] = 0.f;
    float mrun = -INFINITY, lsum = 0.f;
    const char* ksrc[3]; unsigned kstr[3]; const char* vsrc[2];
#pragma unroll
    for (int i = 0; i < 3; ++i) {
        const int s = 64 * (wid * 3 + i) + lane; const int key = s / 24, pos = s - key * 24; const int pc = pos ^ ((key >> 1) & 7);
        const size_t row = (size_t)b * 2048 + key;
        if (pc < 16) { ksrc[i] = (const char*)(KN + row * 1024 + h * 128 + pc * 8); kstr[i] = 2048u; }
        else { ksrc[i] = (const char*)(KPE + row * 64 + (pc - 16) * 8); kstr[i] = 128u; }
    }
#pragma unroll
    for (int i = 0; i < 2; ++i) {
        const int s = 64 * (wid * 2 + i) + lane; const int d = s >> 3, pos = s & 7; const int pc = pos ^ ((d >> 1) & 7);
        vsrc[i] = (const char*)(VT + ((size_t)((b * 8 + h) * 128 + d)) * 2048 + pc * 8);
    }
#define AT_DMA(j) do { const int rowoff = (j) == 0 ? (16384 - b * 2048) : 64 * ((j) - 1); const size_t voff = (j) == 0 ? (size_t)(8 - b) * 8 * 128 * 2048 * 2 : (size_t)128 * ((j) - 1); LAS unsigned char* kb_ = lds + ((j) & 1) * KV_BYTES; \
        _Pragma("unroll") for (int i = 0; i < 3; ++i) __builtin_amdgcn_global_load_lds((const unsigned*)(ksrc[i] + (long)rowoff * (long)kstr[i]), (LAS unsigned*)(kb_ + (wid * 3 + i) * 1024), 16, 0, 0); \
        _Pragma("unroll") for (int i = 0; i < 2; ++i) __builtin_amdgcn_global_load_lds((const unsigned*)(vsrc[i] + voff), (LAS unsigned*)(kb_ + KS_BYTES + (wid * 2 + i) * 1024), 16, 0, 0); } while (0)
    const int key0 = pi32(q);
    const unsigned kbase0 = (unsigned)(key0 * 384) + (unsigned)(((hh ^ ((key0 >> 1) & 7))) << 4);
    const unsigned vbase0 = (unsigned)(q * 128) + (unsigned)((hh ^ ((q >> 1) & 7)) << 4);
    AT_DMA(0); __syncthreads();
    for (int j = 0; j < ntiles; ++j) {
        if (j + 1 < ntiles) AT_DMA(j + 1);
        if (j <= cw) {
            const LAS unsigned char* kb = lds + (j & 1) * KV_BYTES; const LAS unsigned char* vb = kb + KS_BYTES;
            f32x16 s0, s1;
#pragma unroll
            for (int i = 0; i < 16; ++i) { s0[i] = 0.f; s1[i] = 0.f; }
            __builtin_amdgcn_s_setprio(1);
            {
                bf16x8 a0n = *(const LAS bf16x8*)(kb + kbase0), a1n = *(const LAS bf16x8*)(kb + (kbase0 + 32u * 384u));
#pragma unroll
                for (int ks = 0; ks < 12; ++ks) {
                    const bf16x8 a0 = a0n, a1 = a1n;
                    if (ks + 1 < 12) { const unsigned off = (kbase0 ^ (unsigned)(((2 * (ks + 1)) & 7) << 4)) + (unsigned)(((2 * (ks + 1)) & 24) << 4);
                        a0n = *(const LAS bf16x8*)(kb + off); a1n = *(const LAS bf16x8*)(kb + (off + 32u * 384u)); }
                    s0 = __builtin_amdgcn_mfma_f32_32x32x16_bf16(a0, qf[ks], s0, 0, 0, 0);
                    s1 = __builtin_amdgcn_mfma_f32_32x32x16_bf16(a1, qf[ks], s1, 0, 0, 0);
                }
            }
            __builtin_amdgcn_s_setprio(0);
            if (j == 0) {
#pragma unroll
                for (int i = 0; i < 16; ++i) { if (i >= 8) s0[i] = -INFINITY; s1[i] = -INFINITY; }
            }
            float mx = s0[0];
#pragma unroll
            for (int i = 1; i < 16; ++i) mx = fmaxf(mx, s0[i]);
#pragma unroll
            for (int i = 0; i < 16; ++i) mx = fmaxf(mx, s1[i]);
            mx = fmaxf(mx, __shfl_xor(mx, 32));
            const bool upd = __builtin_amdgcn_ballot_w64(mx - mrun > 8.0f) != 0ull;
            const float mn = upd ? fmaxf(mrun, mx) : mrun; const float alpha = upd ? fexp2(mrun - mn) : 1.0f; mrun = mn;
            s0 = s0 - mn; s1 = s1 - mn;
#pragma unroll
            for (int i = 0; i < 16; ++i) { s0[i] = fexp2(s0[i]); s1[i] = fexp2(s1[i]); }
            const f32x16 t16 = s0 + s1;
            typedef float f32x8_ __attribute__((ext_vector_type(8)));
            const f32x8_ t8 = __builtin_shufflevector(t16, t16, 0, 1, 2, 3, 4, 5, 6, 7) + __builtin_shufflevector(t16, t16, 8, 9, 10, 11, 12, 13, 14, 15);
            const f32x4 t4 = __builtin_shufflevector(t8, t8, 0, 1, 2, 3) + __builtin_shufflevector(t8, t8, 4, 5, 6, 7);
            const float ps = (t4[0] + t4[1]) + (t4[2] + t4[3]);
            lsum = lsum * alpha + ps;
            if (upd) {
#pragma unroll
                for (int d = 0; d < 4; ++d)
#pragma unroll
                    for (int i = 0; i < 16; ++i) o[d][i] *= alpha;
            }
#pragma unroll
            for (int kb2 = 0; kb2 < 2; ++kb2)
#pragma unroll
                for (int a = 0; a < 2; ++a) {
                    u32x4 pw;
                    if (kb2 == 0) { pw.x = cvt_pk(s0[8 * a + 0], s0[8 * a + 1]); pw.y = cvt_pk(s0[8 * a + 2], s0[8 * a + 3]); pw.z = cvt_pk(s0[8 * a + 4], s0[8 * a + 5]); pw.w = cvt_pk(s0[8 * a + 6], s0[8 * a + 7]); }
                    else { pw.x = cvt_pk(s1[8 * a + 0], s1[8 * a + 1]); pw.y = cvt_pk(s1[8 * a + 2], s1[8 * a + 3]); pw.z = cvt_pk(s1[8 * a + 4], s1[8 * a + 5]); pw.w = cvt_pk(s1[8 * a + 6], s1[8 * a + 7]); }
                    const bf16x8 pf = __builtin_bit_cast(bf16x8, pw);
                    const unsigned vro = vbase0 ^ (unsigned)((4 * kb2 + 2 * a) << 4);
                    __builtin_amdgcn_s_setprio(1);
#pragma unroll
                    for (int db = 0; db < 4; ++db) {
                        const bf16x8 vf = *(const LAS bf16x8*)(vb + (vro + (unsigned)(db * 4096)));
                        o[db] = __builtin_amdgcn_mfma_f32_32x32x16_bf16(vf, pf, o[db], 0, 0, 0);
                    }
                    __builtin_amdgcn_s_setprio(0);
                }
        }
        __syncthreads();
    }
    {
        const float lt = lsum + __shfl_xor(lsum, 32); const float inv = 1.0f / lt;
        const size_t row = (size_t)b * 2048 + (t0 - 16) + 32 * wid + q; float ss = 0.f;
#pragma unroll
        for (int db = 0; db < 4; ++db)
#pragma unroll
            for (int jj = 0; jj < 4; ++jj) {
                f32x4 v; v[0] = o[db][4 * jj] * inv; v[1] = o[db][4 * jj + 1] * inv; v[2] = o[db][4 * jj + 2] * inv; v[3] = o[db][4 * jj + 3] * inv;
                ss += v[0] * v[0] + v[1] * v[1] + v[2] * v[2] + v[3] * v[3];
                *(u32x2*)(Y + (row * 2048 + 1024 + h * 128 + 32 * db + 8 * jj + 4 * hh)) = pack4(v);
            }
        ss += __shfl_xor(ss, 32);
        if (hh == 0 && ssq_b) atomicAdd(ssq_b + row, ss);
    }
#undef AT_DMA
}

__device__ __forceinline__ float dot8(u32x4 a, u32x4 k) {
    return __builtin_bit_cast(float, a.x << 16) * __builtin_bit_cast(float, k.x << 16) + __builtin_bit_cast(float, a.x & 0xffff0000u) * __builtin_bit_cast(float, k.x & 0xffff0000u)
         + __builtin_bit_cast(float, a.y << 16) * __builtin_bit_cast(float, k.y << 16) + __builtin_bit_cast(float, a.y & 0xffff0000u) * __builtin_bit_cast(float, k.y & 0xffff0000u)
         + __builtin_bit_cast(float, a.z << 16) * __builtin_bit_cast(float, k.z << 16) + __builtin_bit_cast(float, a.z & 0xffff0000u) * __builtin_bit_cast(float, k.z & 0xffff0000u)
         + __builtin_bit_cast(float, a.w << 16) * __builtin_bit_cast(float, k.w << 16) + __builtin_bit_cast(float, a.w & 0xffff0000u) * __builtin_bit_cast(float, k.w & 0xffff0000u);
}
__device__ __forceinline__ void attn_meta(LAS unsigned char* lds, const bf16_t* Q, const bf16_t* KN, const bf16_t* KPE, const bf16_t* VT, bf16_t* Y, float* ssq_b, int b, int h) {
    const int tid = threadIdx.x; LAS float* sc = (LAS float*)lds;
    if (tid < 256) {
        const int qi = tid >> 7, k = (tid >> 3) & 15, part = tid & 7;
        const size_t qrow = (size_t)16384 + 14 + qi, krow = (size_t)16384 + k; float acc = 0.f;
#pragma unroll
        for (int i = 0; i < 3; ++i) { const int pc = part * 3 + i;
            const u32x4 qw = *(const u32x4*)(Q + qrow * 1536 + h * 192 + pc * 8);
            const u32x4 kw = pc < 16 ? *(const u32x4*)(KN + krow * 1024 + h * 128 + pc * 8) : *(const u32x4*)(KPE + krow * 64 + (pc - 16) * 8);
            acc += dot8(qw, kw); }
        acc += __shfl_xor(acc, 1); acc += __shfl_xor(acc, 2); acc += __shfl_xor(acc, 4);
        if (part == 0) sc[qi * 16 + k] = acc;
    }
    __syncthreads();
    if (tid < 256) {
        const int qi = tid >> 7, d = tid & 127; const size_t row = (size_t)16384 + qi;
        float s[16]; float mx = -INFINITY;
#pragma unroll
        for (int k = 0; k < 16; ++k) { s[k] = sc[qi * 16 + k]; mx = fmaxf(mx, s[k]); }
        float l = 0.f;
#pragma unroll
        for (int k = 0; k < 16; ++k) { s[k] = fexp2(s[k] - mx); l += s[k]; }
        const bf16_t* vp = VT + ((size_t)((64 + h) * 128 + d)) * 2048;
        const u32x4 va = *(const u32x4*)vp, vb = *(const u32x4*)(vp + 8);
        float a = s[0] * __builtin_bit_cast(float, va.x << 16) + s[1] * __builtin_bit_cast(float, va.x & 0xffff0000u) + s[2] * __builtin_bit_cast(float, va.y << 16) + s[3] * __builtin_bit_cast(float, va.y & 0xffff0000u)
                + s[4] * __builtin_bit_cast(float, va.z << 16) + s[5] * __builtin_bit_cast(float, va.z & 0xffff0000u) + s[6] * __builtin_bit_cast(float, va.w << 16) + s[7] * __builtin_bit_cast(float, va.w & 0xffff0000u)
                + s[8] * __builtin_bit_cast(float, vb.x << 16) + s[9] * __builtin_bit_cast(float, vb.x & 0xffff0000u) + s[10] * __builtin_bit_cast(float, vb.y << 16) + s[11] * __builtin_bit_cast(float, vb.y & 0xffff0000u)
                + s[12] * __builtin_bit_cast(float, vb.z << 16) + s[13] * __builtin_bit_cast(float, vb.z & 0xffff0000u) + s[14] * __builtin_bit_cast(float, vb.w << 16) + s[15] * __builtin_bit_cast(float, vb.w & 0xffff0000u);
        a = a / l;
        Y[row * 2048 + 1024 + h * 128 + d] = (bf16_t)(cvt_pk(a, 0.f) & 0xffff);
        const float ss = wave_sum(a * a);
        if ((tid & 63) == 0 && ssq_b) atomicAdd(ssq_b + row, ss);
    }
    __syncthreads();
}


#define XB_TMO      128
#define XB_XCNT(j)  (256  + 64 * (j))
#define XB_XSUB(j)  (1280 + 64 * (j))
#define XB_XGEN(j)  (2304 + 64 * (j))
#define XB_TOP      3328
#define XB_TOPGEN   3392
#define XCD_BAR_WORDS 3456
#define XB_SPIN_CAP (1u << 18)
__device__ __forceinline__ unsigned xb_ld(unsigned* p)              { return __hip_atomic_load(p, __ATOMIC_RELAXED, __HIP_MEMORY_SCOPE_AGENT); }
__device__ __forceinline__ unsigned xb_add(unsigned* p, unsigned v) { return __hip_atomic_fetch_add(p, v, __ATOMIC_RELAXED, __HIP_MEMORY_SCOPE_AGENT); }
__device__ __forceinline__ unsigned xb_xcc_id() { return (unsigned)__builtin_amdgcn_s_getreg((3 << 11) | 20) & 0xFu; }
#define XB_SPIN(cond, bar) do { unsigned _sp = 0; while (cond) { __builtin_amdgcn_s_sleep(1); \
    if ((++_sp & 255u) == 0u) { if (xb_ld(&(bar)[XB_TMO])) break; if (_sp > XB_SPIN_CAP) { atomicAdd(&(bar)[XB_TMO], 1u); break; } } } } while (0)
struct XcdBarrier { unsigned* bar; unsigned x; volatile LAS unsigned* st; };
__device__ __forceinline__ XcdBarrier xcd_barrier_post(unsigned* bar, volatile LAS unsigned* st) {
    XcdBarrier b; b.bar = bar; b.x = xb_xcc_id(); b.st = st;
    if (threadIdx.x == 0) (void)xb_add(&bar[XB_XCNT(b.x)], 1u);
    return b;
}
__device__ __forceinline__ void xcd_barrier_complete(unsigned* bar, unsigned x, unsigned& nloc, unsigned& nx) {
    const unsigned G = gridDim.x * gridDim.y * gridDim.z;
    unsigned sum, cnt, mine, sp = 0u;
    for (;;) {
        sum = 0u; cnt = 0u; mine = 0u;
#pragma unroll
        for (unsigned j = 0; j < 16; ++j) { const unsigned c = xb_ld(&bar[XB_XCNT(j)]); sum += c; cnt += (c > 0u) ? 1u : 0u; mine = (j == x) ? c : mine; }
        if (sum == G) break;
        __builtin_amdgcn_s_sleep(1);
        if ((++sp & 255u) == 0u) { if (xb_ld(&bar[XB_TMO])) break; if (sp > XB_SPIN_CAP) { atomicAdd(&bar[XB_TMO], 1u); break; } }
    }
    nloc = mine > 0u ? mine : 1u; nx = cnt > 0u ? cnt : 1u;
}
__device__ __forceinline__ void xcd_barrier(const XcdBarrier& b) {
    asm volatile("s_waitcnt vmcnt(0)" ::: "memory");
    __syncthreads();
    if (threadIdx.x == 0) {
        unsigned* bar = b.bar;
        __builtin_amdgcn_s_waitcnt(0);
        unsigned nloc = b.st[0], nx = b.st[1];
        if (nloc == 0u) { xcd_barrier_complete(bar, b.x, nloc, nx); b.st[0] = nloc; b.st[1] = nx; }
        const unsigned old = xb_add(&bar[XB_XSUB(b.x)], 1u);
        const unsigned gen = old / nloc;
        if (old + 1u == (gen + 1u) * nloc) {
            __builtin_amdgcn_fence(__ATOMIC_RELEASE, "agent");
            asm volatile("s_waitcnt vmcnt(0)" ::: "memory");
            const unsigned og = xb_add(&bar[XB_TOP], 1u);
            const unsigned tg = og / nx;
            if (og + 1u == (tg + 1u) * nx) xb_add(&bar[XB_TOPGEN], 1u);
            else XB_SPIN(xb_ld(&bar[XB_TOPGEN]) == tg, bar);
            __builtin_amdgcn_fence(__ATOMIC_ACQUIRE, "agent");
            xb_add(&bar[XB_XGEN(b.x)], 1u);
            asm volatile("s_waitcnt vmcnt(0)" ::: "memory");
        } else {
            XB_SPIN(xb_ld(&bar[XB_XGEN(b.x)]) == gen, bar);
            __builtin_amdgcn_fence(__ATOMIC_ACQUIRE, "agent");
            asm volatile("s_waitcnt vmcnt(0)" ::: "memory");
        }
    }
    __syncthreads();
}

__global__ void __launch_bounds__(NTHR, 2) fwd_megakernel(Params p) {
    extern __shared__ __attribute__((aligned(16))) unsigned char smem[];
    LAS unsigned char* lds = (LAS unsigned char*)smem;
    cg::grid_group grid = cg::this_grid();
    const int tid = threadIdx.x, lane = tid & 63, wid = tid >> 6, G = gridDim.x, bid = blockIdx.x;
    const long gtid = (long)bid * NTHR + tid, gthreads = (long)G * NTHR;
    unsigned char* ws = p.ws;
    bf16_t* WinT = (bf16_t*)(ws + O_WIN); bf16_t* WgluT = (bf16_t*)(ws + O_WGLU); bf16_t* WqT = (bf16_t*)(ws + O_WQ); bf16_t* WkvT = (bf16_t*)(ws + O_WKV);
    bf16_t* WoutT = (bf16_t*)(ws + O_WOUT); bf16_t* WupT = (bf16_t*)(ws + O_WUP); bf16_t* WdT = (bf16_t*)(ws + O_WD);
    bf16_t* MST = (bf16_t*)(ws + O_MST); bf16_t* MIO = (bf16_t*)(ws + O_MIO); float* KD = (float*)(ws + O_KD);
    float2* PWC = (float2*)(ws + O_PWC); float2* PW1 = (float2*)(ws + O_PW1); float* COS = (float*)(ws + O_COS); float* SIN = (float*)(ws + O_SIN);
    float* ssq_q = (float*)(ws + O_SSQ); float* ssq_kv = ssq_q + MPAD; float* ssq_a = ssq_kv + MPAD; float* ssq_b = ssq_a + MPAD; float* ssq_h = ssq_b + MPAD; float* ssq_o = ssq_h + MPAD; float* rinvx = ssq_o + MPAD;
    bf16_t* Y = (bf16_t*)(ws + O_Y); bf16_t* XN = (bf16_t*)(ws + O_XN); bf16_t* XS = (bf16_t*)(ws + O_XS); bf16_t* QA = (bf16_t*)(ws + O_QA); bf16_t* KVA = (bf16_t*)(ws + O_KVA);
    bf16_t* KPE = (bf16_t*)(ws + O_KPE); bf16_t* Qb = (bf16_t*)(ws + O_Q); bf16_t* KN = (bf16_t*)(ws + O_KN); bf16_t* VT = (bf16_t*)(ws + O_VT); float* Sst = (float*)(ws + O_S);
    bf16_t* Gb = (bf16_t*)(ws + O_G); bf16_t* XH = (bf16_t*)(ws + O_XH); bf16_t* ACT = (bf16_t*)(ws + O_ACT);
    const float* x = p.in[0]; const float* meta = p.in[1];
    unsigned* barw = (unsigned*)(ws + O_BAR);
    volatile LAS unsigned* bst = (volatile LAS unsigned*)(lds + STAGE_BYTES + 16384);
    if (tid < 4) bst[tid] = 0u;
    __syncthreads();
    XcdBarrier xbar; xbar.bar = barw; xbar.x = 0; xbar.st = bst;

#if PH_ON(0)
#pragma unroll 1
    for (int rep = 0; rep < 1 + DUP_ON(0); ++rep)
    {
        for (long i = gtid; i < 6 * MPAD; i += gthreads) ssq_q[i] = 0.f;
        if (bid == 0) for (int i = tid; i < 4096; i += NTHR) barw[i] = 0u;
        for (long i = gtid; i < 1024 * 6; i += gthreads) { const int r = (int)(i / 6), pc = (int)(i % 6); *(u32x4*)(VT + ((size_t)(64 * 128 + r)) * 2048 + 16 + pc * 8) = (u32x4){0u, 0u, 0u, 0u}; }
        for (long i = gtid; i < LL * 32; i += gthreads) { const int pos = (int)(i >> 5), j = (int)(i & 31); const float invf = 1.0f / powf(10000.0f, (float)(2 * j) / 64.0f); const float ang = (float)pos * invf; COS[i] = cosf(ang); SIN[i] = sinf(ang); }
        for (long idx = gtid; idx < 4096 * 16; idx += gthreads) {
            const long i = idx >> 4; const int d = (int)(idx & 15); const int g = (int)(i >> 6);
            const float lr = p.in[4][i], li = p.in[5][i], dt = expf(p.in[6][g]); const float zr = lr * dt, zi = li * dt;
            const float er = expf(zr); const float lbr = er * cosf(zi), lbi = er * sinf(zi);
            const float nr = lbr - 1.0f, ni = lbi, den = lr * lr + li * li;
            const float cr = (nr * lr + ni * li) / den, ci = (ni * lr - nr * li) / den;
            const float e0 = expf(zr * (float)d), a0 = zi * (float)d; const float pr = e0 * cosf(a0), pi = e0 * sinf(a0);
            PWC[idx] = make_float2(pr * cr - pi * ci, pr * ci + pi * cr);
            const float e1 = expf(zr * (float)(d + 1)), a1 = zi * (float)(d + 1);
            PW1[idx] = make_float2(e1 * cosf(a1), e1 * sinf(a1));
        }
        for (int row = bid * 8 + wid; row < 16384 + NMETA; row += G * 8) {
            bf16_t* orow = XN + (size_t)row * 2048;
            const float* hrow = (row >= 16384) ? meta + (size_t)(row - 16384) * 2048 : x + (size_t)row * 2048;
            f32x4 v[8]; float ss = 0.f;
#pragma unroll
            for (int i = 0; i < 4; ++i) { v[2 * i] = __builtin_nontemporal_load((const f32x4*)(hrow + i * 512 + lane * 8)); v[2 * i + 1] = __builtin_nontemporal_load((const f32x4*)(hrow + i * 512 + lane * 8 + 4)); }
#pragma unroll
            for (int i = 0; i < 8; ++i) ss += v[i][0] * v[i][0] + v[i][1] * v[i][1] + v[i][2] * v[i][2] + v[i][3] * v[i][3];
            ss = wave_sum(ss); const float rs = rsqrtf(ss * (1.0f / 2048.0f) + EPS);
            if (lane == 0) rinvx[row] = 1.0f / rs;
#pragma unroll
            for (int i = 0; i < 4; ++i) {
                const f32x4 g0 = *(const f32x4*)(p.in[2] + i * 512 + lane * 8), g1 = *(const f32x4*)(p.in[2] + i * 512 + lane * 8 + 4);
                const f32x4 a = v[2 * i] * rs * g0, c = v[2 * i + 1] * rs * g1; u32x4 w; w.x = cvt_pk(a[0], a[1]); w.y = cvt_pk(a[2], a[3]); w.z = cvt_pk(c[0], c[1]); w.w = cvt_pk(c[2], c[3]);
                *(u32x4*)(orow + i * 512 + lane * 8) = w;
            }
        }
        LAS float* scr = (LAS float*)lds;
        constexpr int T0 = 32 * 16, T1 = T0 + 16 * 8, T2 = T1 + 24 * 4, T3 = T2 + 32 * 2, T4 = T3 + 32 * 16, T5 = T4 + 172 * 16, T6 = T5 + 32 * 43;
        for (int it = bid; it < T6; it += G) {
            if (it < T0) { transpose_tile<0>(p, WinT, 2048, 1856, p.in[3], it % 32, it / 32, scr, tid); }
            else if (it < T1) { const int j = it - T0; transpose_tile<1>(p, WgluT, 1024, 1024, p.in[12], j % 16, j / 16, scr, tid); }
            else if (it < T2) { const int j = it - T1; transpose_tile<2>(p, WqT, 512, 1536, p.in[15], j % 24, j / 24, scr, tid); }
            else if (it < T3) { const int j = it - T2; transpose_tile<3>(p, WkvT, 256, 2048, p.in[17], j % 32, j / 32, scr, tid); }
            else if (it < T4) { const int j = it - T3; transpose_tile<4>(p, WoutT, 2048, 2048, p.in[20], j % 32, j / 32, scr, tid); }
            else if (it < T5) { const int j = it - T4; transpose_tile<5>(p, WupT, 2048, 2 * DFF, p.in[22], j % 172, j / 172, scr, tid); }
            else { const int j = it - T5; transpose_tile<6>(p, WdT, DFF, 2048, p.in[25], j % 32, j / 32, scr, tid); }
        }
    grid.sync();
    if (rep == 0) xbar = xcd_barrier_post(barw, bst);
    }

#endif
#if PH_ON(1)
#pragma unroll 1
    for (int rep = 0; rep < 1 + DUP_ON(1); ++rep)
    {
        const float* b_re = p.in[7]; const float* b_im = p.in[8]; const float* c_re = p.in[9]; const float* c_im = p.in[10];
        {
            LAS float* Bre = (LAS float*)lds; LAS float* Bim = Bre + 1024; LAS float* Cre = Bim + 1024; LAS float* Cim = Cre + 1024; LAS float* Wre = Cim + 1024; LAS float* Wim = Wre + 256;
            for (int wi = bid; wi < 256; wi += G) {
                const int g = wi >> 2, dq = wi & 3;
                if (tid < 256) {
                    ((LAS f32x4*)Bre)[tid] = ((const f32x4*)(b_re + g * 1024))[tid]; ((LAS f32x4*)Bim)[tid] = ((const f32x4*)(b_im + g * 1024))[tid];
                    ((LAS f32x4*)Cre)[tid] = ((const f32x4*)(c_re + g * 1024))[tid]; ((LAS f32x4*)Cim)[tid] = ((const f32x4*)(c_im + g * 1024))[tid];
                    const int q = tid & 63, dd = tid >> 6; const float2 w = PWC[(g * 64 + q) * 16 + 4 * dq + dd]; Wre[dd * 64 + q] = w.x; Wim[dd * 64 + q] = w.y;
                }
                __syncthreads();
#pragma unroll
                for (int j = 0; j < 2; ++j) {
                    const int o = tid + 512 * j, dd = o >> 8, c = (o >> 4) & 15, c2 = o & 15; float acc = 0.f;
#pragma unroll 8
                    for (int q = 0; q < 64; ++q) {
                        const float cr = Cre[c * 64 + q], ci = Cim[c * 64 + q], wr_ = Wre[dd * 64 + q], wi_ = Wim[dd * 64 + q];
                        const float tr = cr * wr_ - ci * wi_, ti = cr * wi_ + ci * wr_;
                        acc += tr * Bre[q * 16 + c2] - ti * Bim[q * 16 + c2];
                    }
                    KD[((g * 16 + 4 * dq + dd) * 16 + c) * 16 + c2] = acc;
                }
                __syncthreads();
            }
        }
        for (long i = gtid; i < (long)64 * 256 * 16; i += gthreads) {
            const int g = (int)(i >> 12), n = (int)(i >> 4) & 255, sx = (int)i & 15; u32x4 o0 = (u32x4){0u, 0u, 0u, 0u}, o1 = o0;
            if (n < 128) {
                const int q = n & 63; const float2 w = PWC[(g * 64 + q) * 16 + (15 - sx)];
                const float* brp = b_re + (g * 64 + q) * 16; const float* bip = b_im + (g * 64 + q) * 16; float v[16];
#pragma unroll
                for (int e = 0; e < 4; ++e) { const f32x4 br = *(const f32x4*)(brp + 4 * e), bi = *(const f32x4*)(bip + 4 * e);
#pragma unroll
                    for (int u2 = 0; u2 < 4; ++u2) v[4 * e + u2] = (n < 64) ? (w.x * br[u2] - w.y * bi[u2]) : (w.x * bi[u2] + w.y * br[u2]); }
                o0.x = cvt_pk(v[0], v[1]); o0.y = cvt_pk(v[2], v[3]); o0.z = cvt_pk(v[4], v[5]); o0.w = cvt_pk(v[6], v[7]);
                o1.x = cvt_pk(v[8], v[9]); o1.y = cvt_pk(v[10], v[11]); o1.z = cvt_pk(v[12], v[13]); o1.w = cvt_pk(v[14], v[15]);
            }
            u32x4* dst = (u32x4*)(MST + ((size_t)(g * 256 + n) * 256 + sx * 16)); dst[0] = o0; dst[1] = o1;
        }
        for (long i = gtid; i < (long)64 * 256 * 8; i += gthreads) {
            const int g = (int)(i >> 11), n = (int)(i >> 3) & 255, j = (int)i & 7; const int kk0 = 16 * j, q0 = kk0 & 63, t = n >> 4, c = n & 15; const bool neg = kk0 >= 64;
            const float* crp = c_re + (g * 16 + c) * 64 + q0; const float* cip = c_im + (g * 16 + c) * 64 + q0;
            f32x4 cr[4], ci[4]; float2 w[16];
#pragma unroll
            for (int e = 0; e < 4; ++e) { cr[e] = *(const f32x4*)(crp + 4 * e); ci[e] = *(const f32x4*)(cip + 4 * e); }
#pragma unroll
            for (int e = 0; e < 16; ++e) w[e] = PW1[(g * 64 + q0 + e) * 16 + t];
            float v[16];
#pragma unroll
            for (int e = 0; e < 16; ++e) { const float a = cr[e >> 2][e & 3], bq = ci[e >> 2][e & 3]; v[e] = neg ? -(a * w[e].y + bq * w[e].x) : (a * w[e].x - bq * w[e].y); }
            u32x4 o0, o1; o0.x = cvt_pk(v[0], v[1]); o0.y = cvt_pk(v[2], v[3]); o0.z = cvt_pk(v[4], v[5]); o0.w = cvt_pk(v[6], v[7]);
            o1.x = cvt_pk(v[8], v[9]); o1.y = cvt_pk(v[10], v[11]); o1.z = cvt_pk(v[12], v[13]); o1.w = cvt_pk(v[14], v[15]);
            u32x4* dst = (u32x4*)(MIO + ((size_t)(g * 256 + n) * XSK + 256 + kk0)); dst[0] = o0; dst[1] = o1;
        }
        {
            LAS f32x4* red = (LAS f32x4*)lds;
            const int fr = lane & 15, fq = lane >> 4;
            for (int task = bid; task < 114; task += G) {
                const bool pair = task >= 112;
                const int g0 = pair ? 112 + 2 * (task - 112) : task;
                f32x4 c0 = (f32x4){0.f, 0.f, 0.f, 0.f}, c1 = c0;
#pragma unroll
                for (int i = 0; i < 8; ++i) {
                    const int k = wid * 256 + i * 32 + 8 * fq;
                    const bf16x8 af = *(const bf16x8*)(XN + (size_t)(16384 + fr) * 2048 + k);
                    const bf16x8 b0 = *(const bf16x8*)(WinT + (size_t)(g0 * 16 + fr) * 2048 + k);
                    c0 = __builtin_amdgcn_mfma_f32_16x16x32_bf16(b0, af, c0, 0, 0, 0);
                    if (pair) { const bf16x8 b1 = *(const bf16x8*)(WinT + (size_t)(g0 * 16 + 16 + fr) * 2048 + k); c1 = __builtin_amdgcn_mfma_f32_16x16x32_bf16(b1, af, c1, 0, 0, 0); }
                }
                red[wid * 64 + lane] = c0; red[512 + wid * 64 + lane] = c1;
                __syncthreads();
                if (wid == 0) {
                    f32x4 v0 = red[lane], v1 = red[512 + lane];
#pragma unroll
                    for (int w2 = 1; w2 < 8; ++w2) { v0 += red[w2 * 64 + lane]; v1 += red[512 + w2 * 64 + lane]; }
                    const int t = fr;
                    if (g0 < 64) { *(u32x2*)(XS + ((size_t)(g0 * GRP + 1024)) * XSK + t * 16 + 4 * fq) = pack4(v0); }
                    else if (g0 < 112) {
                        float ss = v0[0] * v0[0] + v0[1] * v0[1] + v0[2] * v0[2] + v0[3] * v0[3];
                        if (g0 < 96) *(u32x2*)(QA + (size_t)(16384 + t) * 512 + (g0 - 64) * 16 + 4 * fq) = pack4(v0);
                        else *(u32x2*)(KVA + (size_t)(16384 + t) * 256 + (g0 - 96) * 16 + 4 * fq) = pack4(v0);
                        ss += __shfl_xor(ss, 16); ss += __shfl_xor(ss, 32);
                        if (fq == 0) atomicAdd((g0 < 96 ? ssq_q : ssq_kv) + 16384 + t, ss);
                    } else {
                        const int pp = 32 * (task - 112) + 4 * fq, j = 16 * (task - 112) + 4 * fq;
                        const f32x4 c = *(const f32x4*)(COS + t * 32 + j), sn_ = *(const f32x4*)(SIN + t * 32 + j); f32x4 y1, y2;
#pragma unroll
                        for (int e = 0; e < 4; ++e) { y1[e] = v0[e] * c[e] - v1[e] * sn_[e]; y2[e] = v1[e] * c[e] + v0[e] * sn_[e]; }
                        *(u32x2*)(KPE + (size_t)(16384 + t) * 64 + pp) = pack4(y1); *(u32x2*)(KPE + (size_t)(16384 + t) * 64 + pp + 16) = pack4(y2);
                    }
                }
                __syncthreads();
            }
        }
        GSched<0> S; S.init(XN, WinT, 2048, 2048, 64, 8, 1, 0, 0);
        EpiZ E{XS, QA, KVA, KPE, rep ? nullptr : ssq_q, ssq_kv, COS, SIN};
        gemm_phase(lds, S, E);
    xcd_barrier(xbar);
    }

#endif
#if PH_ON(2)
    {
        const int fb0 = (G == 256) ? 128 : 0;
        for (long i = (long)(bid - fb0) * NTHR + tid; bid >= fb0 && i < (long)64 * 256 * 16; i += (long)(G - fb0) * NTHR) {
            const int g = (int)(i >> 12), n = (int)(i >> 4) & 255, sx = (int)i & 15; const int t = n >> 4, c = n & 15;
            u32x4 o0 = (u32x4){0u, 0u, 0u, 0u}, o1 = o0;
            if (sx <= t) { const float* kp = KD + ((g * 16 + (t - sx)) * 16 + c) * 16; const f32x4 a0 = *(const f32x4*)kp, a1 = *(const f32x4*)(kp + 4), a2 = *(const f32x4*)(kp + 8), a3 = *(const f32x4*)(kp + 12);
                o0.x = cvt_pk(a0[0], a0[1]); o0.y = cvt_pk(a0[2], a0[3]); o0.z = cvt_pk(a1[0], a1[1]); o0.w = cvt_pk(a1[2], a1[3]);
                o1.x = cvt_pk(a2[0], a2[1]); o1.y = cvt_pk(a2[2], a2[3]); o1.z = cvt_pk(a3[0], a3[1]); o1.w = cvt_pk(a3[2], a3[3]); }
            u32x4* dst = (u32x4*)(MIO + ((size_t)(g * 256 + n) * XSK + sx * 16)); dst[0] = o0; dst[1] = o1;
        }
        for (int col = bid * 8 + wid; col < 2048; col += G * 8) {
            const u32x2 w = *(const u32x2*)(WkvT + (size_t)col * 256 + lane * 4); float v = 0.f;
#pragma unroll
            for (int r = 0; r < 16; ++r) { const float s_ = wave_sum(dot4(*(const u32x2*)(KVA + (size_t)(16384 + r) * 256 + lane * 4), w)); if (lane == r) v = s_; }
            if (lane < 16) { v *= rsqrtf(ssq_kv[16384 + lane] * (1.0f / 256.0f) + EPS); const int hd = col >> 8, wi = col & 255;
                if (wi < 128) KN[(size_t)(16384 + lane) * 1024 + hd * 128 + wi] = f2bf(v); else VT[((size_t)((64 + hd) * 128 + wi - 128)) * 2048 + lane] = f2bf(v); }
        }
        for (int task = bid * 8 + wid; task < 1280; task += G * 8) {
            const bool pair = task >= 1024; int n0, n1, j = 0;
            if (!pair) { n0 = 192 * (task >> 7) + (task & 127); n1 = n0; }
            else { const int pidx = task - 1024, hq = pidx >> 5, pq = pidx & 31, pp = (pq >> 4) * 32 + (pq & 15); n0 = 192 * hq + 128 + pp; n1 = n0 + 16; j = (pp >> 5) * 16 + (pp & 15); }
            const u32x4 w0 = *(const u32x4*)(WqT + (size_t)n0 * 512 + lane * 8), w1 = *(const u32x4*)(WqT + (size_t)n1 * 512 + lane * 8);
            const u32x4 x0 = *(const u32x4*)(QA + (size_t)(16384 + 14) * 512 + lane * 8), x1 = *(const u32x4*)(QA + (size_t)(16384 + 15) * 512 + lane * 8);
            const float p00 = wave_sum(dot8(x0, w0)), p01 = wave_sum(dot8(x0, w1)), p10 = wave_sum(dot8(x1, w0)), p11 = wave_sum(dot8(x1, w1));
            if (lane < 2) { const int t = 14 + lane; const float rs = rsqrtf(ssq_q[16384 + t] * (1.0f / 512.0f) + EPS) * QSCALE;
                float y0 = (lane ? p10 : p00) * rs, y1 = (lane ? p11 : p01) * rs;
                if (pair) { const float c = COS[t * 32 + j], sn_ = SIN[t * 32 + j]; const float z0 = y0 * c - y1 * sn_, z1 = y1 * c + y0 * sn_; y0 = z0; y1 = z1; }
                Qb[(size_t)(16384 + t) * 1536 + n0] = f2bf(y0); if (pair) Qb[(size_t)(16384 + t) * 1536 + n1] = f2bf(y1); }
        }
        for (int t4 = (bid * 8 + wid) * 4; t4 < 64 * 128; t4 += G * 32) {
            const int g = t4 >> 7, n0_ = t4 & 127;
            const u32x2 xv = *(const u32x2*)(XS + ((size_t)(g * GRP + 1024)) * XSK + lane * 4);
            u32x2 mv[4];
#pragma unroll
            for (int i = 0; i < 4; ++i) mv[i] = *(const u32x2*)(MST + ((size_t)(g * 256 + n0_ + i)) * 256 + lane * 4);
            float r4[4];
#pragma unroll
            for (int i = 0; i < 4; ++i) r4[i] = wave_sum(dot4(xv, mv[i]));
            if (lane == 0) *(f32x4*)(Sst + ((size_t)(g * GRP + 1024)) * 128 + n0_) = (f32x4){r4[0], r4[1], r4[2], r4[3]};
        }
        { GSched<0> S; S.init(QA, WqT, 512, 512, 64, 6, 1, 0, 0); EpiQ E{Qb, ssq_q, COS, SIN}; gemm_phase(lds, S, E); }
        { GSched<0> S; S.init(KVA, WkvT, 256, 256, 64, 8, 1, 0, 0); EpiKV E{KN, VT, ssq_kv}; gemm_phase(lds, S, E); }
        { GSched<0> S; S.init(XS, MST, XSK, 256, 4, 1, 64, (size_t)GRP * XSK * 2, (size_t)256 * 256 * 2); EpiS E{Sst}; gemm_phase(lds, S, E); }
    }
    xcd_barrier(xbar);

#endif
#if PH_ON(3)
#pragma unroll 1
    for (int rep = 0; rep < 1 + DUP_ON(3); ++rep)
    {
        float* ssq_b_ = rep ? nullptr : ssq_b;
#ifndef NO_SCAN
        {
            LAS float* tb = (LAS float*)lds;
            for (int base = bid * 128; base < NB * 64 * 64; base += G * 128) {
                const int cl = tid & 127, seg = tid >> 7, ch = base + cl;
                const int q = ch & 63, g = (ch >> 6) & 63, b = ch >> 12;
                const float2 l16 = PW1[(g * 64 + q) * 16 + 15];
                const float* sp = Sst + ((size_t)(g * GRP + b * 128 + 32 * seg)) * 128 + q; bf16_t* xp = XS + ((size_t)(g * GRP + b * 128 + 32 * seg)) * XSK + 256 + q;
                float sr[32], si[32];
#pragma unroll
                for (int k = 0; k < 32; ++k) { sr[k] = sp[(size_t)k * 128]; si[k] = sp[(size_t)k * 128 + 64]; }
                float hr = 0.f, hi = 0.f;
#pragma unroll
                for (int k = 0; k < 32; ++k) { const float nr = l16.x * hr - l16.y * hi + sr[k], ni = l16.x * hi + l16.y * hr + si[k]; hr = nr; hi = ni; }
                tb[(seg * 128 + cl) * 2] = hr; tb[(seg * 128 + cl) * 2 + 1] = hi;
                __syncthreads();
                float pr = l16.x, pi = l16.y;
#pragma unroll
                for (int e = 0; e < 5; ++e) { const float nr = pr * pr - pi * pi, ni = 2.0f * pr * pi; pr = nr; pi = ni; }
                hr = Sst[((size_t)(g * GRP + 1024)) * 128 + q]; hi = Sst[((size_t)(g * GRP + 1024)) * 128 + 64 + q];
#pragma unroll
                for (int s2 = 0; s2 < 3; ++s2) { if (s2 < seg) { const float t2x = tb[(s2 * 128 + cl) * 2], t2y = tb[(s2 * 128 + cl) * 2 + 1]; const float nr = pr * hr - pi * hi + t2x, ni = pr * hi + pi * hr + t2y; hr = nr; hi = ni; } }
#pragma unroll
                for (int k = 0; k < 32; ++k) {
                    xp[(size_t)k * XSK] = f2bf(hr); xp[(size_t)k * XSK + 64] = f2bf(hi);
                    const float nr = l16.x * hr - l16.y * hi + sr[k], ni = l16.x * hi + l16.y * hr + si[k]; hr = nr; hi = ni;
                }
                __syncthreads();
            }
        }
#endif
#ifndef NO_ATTN
        for (int pid = bid; pid < 256; pid += G) {
            const int bh = (pid & 7) * 8 + (pid >> 5), xq = (pid >> 3) & 3;
            attn_unit(lds, Qb, KN, KPE, VT, Y, ssq_b_, bh >> 3, bh & 7, 7 - xq);
            attn_unit(lds, Qb, KN, KPE, VT, Y, ssq_b_, bh >> 3, bh & 7, xq);
        }
#endif
#ifndef NO_META
        for (int pid = bid; pid < 8; pid += G) attn_meta(lds, Qb, KN, KPE, VT, Y, ssq_b_, 0, pid);
#endif
    xcd_barrier(xbar);
    }

#endif
#if PH_ON(4)
    for (int task = bid * 8 + wid; task < 2048; task += G * 8) {
        const int g = task >> 5, i2 = (task >> 4) & 1, c = task & 15, n = (14 + i2) * 16 + c;
        const float v = wave_sum(dot4(*(const u32x2*)(XS + ((size_t)(g * GRP + 1024)) * XSK + lane * 4), *(const u32x2*)(MIO + ((size_t)(g * 256 + n)) * XSK + lane * 4)));
        if (lane == 0) { const float a = v + p.in[11][g * 16 + c] * bf2f(XS[((size_t)(g * GRP + 1024)) * XSK + n]);
            Gb[(size_t)(16384 + i2) * 1024 + g * 16 + c] = f2bf(a * sigmoidf_(1.5957691216f * (a + 0.044715f * a * a * a))); }
    }
    { GSched<0> S; S.init(XS, MIO, XSK, XSK, 4, 1, 64, (size_t)GRP * XSK * 2, (size_t)256 * XSK * 2); EpiY E{XS, Gb, p.in[11]}; gemm_phase(lds, S, E); }
    xcd_barrier(xbar);

#endif
#if PH_ON(5)
    {
        LAS float* red = (LAS float*)lds;
        for (int c0_ = bid * 4; c0_ < 1024; c0_ += G * 4) {
            float ssl0 = 0.f, ssl1 = 0.f;
            if (wid < 4) {
                const int col = c0_ + wid; float a0 = 0.f, a1 = 0.f;
#pragma unroll
                for (int hk = 0; hk < 2; ++hk) { const int k = lane * 16 + hk * 8;
                    const u32x4 w = *(const u32x4*)(WgluT + (size_t)col * 1024 + k);
                    a0 += dot8(*(const u32x4*)(Gb + (size_t)16384 * 1024 + k), w); a1 += dot8(*(const u32x4*)(Gb + (size_t)16385 * 1024 + k), w); }
                a0 = wave_sum(a0); a1 = wave_sum(a1);
                const float bb = p.in[13][col];
                const float o0 = bf2f(Gb[(size_t)16384 * 1024 + col]) * sigmoidf_(a0 + bb), o1 = bf2f(Gb[(size_t)16385 * 1024 + col]) * sigmoidf_(a1 + bb);
                if (lane == 0) { Y[(size_t)16384 * 2048 + col] = (bf16_t)(cvt_pk(o0, 0.f) & 0xffff); Y[(size_t)16385 * 2048 + col] = (bf16_t)(cvt_pk(o1, 0.f) & 0xffff); }
                ssl0 = o0 * o0; ssl1 = o1 * o1;
            }
            if (lane == 0) { red[wid * 2] = ssl0; red[wid * 2 + 1] = ssl1; }
            __syncthreads();
            if (tid < 2) { float t_ = 0.f; for (int w2 = 0; w2 < 8; ++w2) t_ += red[w2 * 2 + tid]; atomicAdd(ssq_a + 16384 + tid, t_); }
            __syncthreads();
        }
    }
    { GSched<0> S; S.init(Gb, WgluT, 1024, 1024, 64, 4, 1, 0, 0); EpiGlu E{Gb, Y, p.in[13], ssq_a}; gemm_phase(lds, S, E); }
    xcd_barrier(xbar);

#endif
#if PH_ON(6)
    {
        LAS float* red = (LAS float*)lds;
        const float sc0 = (lane < 32) ? rsqrtf(ssq_a[16384] * (1.0f / 1024.0f) + EPS) : rsqrtf(ssq_b[16384] * (1.0f / 1024.0f) + EPS);
        const float sc1 = (lane < 32) ? rsqrtf(ssq_a[16385] * (1.0f / 1024.0f) + EPS) : rsqrtf(ssq_b[16385] * (1.0f / 1024.0f) + EPS);
        for (int c0_ = bid * 8; c0_ < 2048; c0_ += G * 8) {
            const int col = c0_ + wid; float a0 = 0.f, a1 = 0.f;
#pragma unroll
            for (int hk = 0; hk < 4; ++hk) { const int k = lane * 32 + hk * 8;
                const u32x4 w = *(const u32x4*)(WoutT + (size_t)col * 2048 + k);
                a0 += dot8(*(const u32x4*)(Y + (size_t)16384 * 2048 + k), w); a1 += dot8(*(const u32x4*)(Y + (size_t)16385 * 2048 + k), w); }
            a0 *= sc0; a1 *= sc1;
            a0 = wave_sum(a0); a1 = wave_sum(a1);
            const float h0 = meta[(size_t)14 * 2048 + col] + a0, h1v = meta[(size_t)15 * 2048 + col] + a1;
            if (lane < 16) { const int bb = lane >> 1, ii = lane & 1; XH[(size_t)(bb * XHB + ii) * 2048 + col] = (bf16_t)(cvt_pk(ii ? h1v : h0, 0.f) & 0xffff); }
            if (lane == 0) { red[wid * 2] = h0 * h0; red[wid * 2 + 1] = h1v * h1v; }
            __syncthreads();
            if (tid < 16) { const int ii = tid & 1; float t_ = 0.f; for (int w2 = 0; w2 < 8; ++w2) t_ += red[w2 * 2 + ii]; atomicAdd(ssq_h + (tid >> 1) * XHB + ii, t_); }
            __syncthreads();
        }
    }
    { GSched<0> S; S.init(Y, WoutT, 2048, 2048, 64, 8, 1, 0, 0); EpiOut E{ssq_a, ssq_b, XN, rinvx, p.in[2], XH, ssq_h}; gemm_phase(lds, S, E); }
    xcd_barrier(xbar);

#endif
#if PH_ON(7)
#pragma unroll 1
    for (int rep = 0; rep < 1 + DUP_ON(7); ++rep)
    { { GSched<1> S; S.init(XH, WupT, 2048, 2048, 65, 43, 1, 0, 0); EpiUp E{ACT, ssq_h, p.in[23], p.in[24]}; gemm_phase(lds, S, E); }
    xcd_barrier(xbar); }

#endif
#if PH_ON(8)
    if (G == 256) { GSched<2> S; S.init(ACT, WdT, DFF, DFF, 64, 8, 1, 0, 0); EpiDownNorm E{XH, p.out, ssq_o, barw + 3584, p.in[26]}; gemm_phase(lds, S, E); }
    else { GSched<0> S; S.init(ACT, WdT, DFF, DFF, 64, 8, 1, 0, 0); EpiDown E{XH, Y, ssq_o}; gemm_phase(lds, S, E); }
    if (G != 256) xcd_barrier(xbar);

#endif
#if PH_ON(9)
    if (G != 256)
    for (int row = bid * 8 + wid; row < 16384; row += G * 8) {
        float* orow = p.out + (size_t)row * 2048; const bf16_t* hrow = Y + (size_t)row * 2048; const float rs = rsqrtf(ssq_o[row] * (1.0f / 2048.0f) + EPS);
#pragma unroll
        for (int i = 0; i < 4; ++i) { const int c = i * 512 + lane * 8; const u32x4 w = *(const u32x4*)(hrow + c);
            u32x2 lo; lo.x = w.x; lo.y = w.y; u32x2 hi; hi.x = w.z; hi.y = w.w;
            *(f32x4*)(orow + c) = unpack4(lo) * rs * *(const f32x4*)(p.in[26] + c); *(f32x4*)(orow + c + 4) = unpack4(hi) * rs * *(const f32x4*)(p.in[26] + c + 4); }
    }
#endif
}

extern "C" void kernel_launch(void* const* d_in, const int* in_sizes, int n_in, void* d_out, int out_size, void* d_ws, size_t ws_size, hipStream_t stream) {
    static int grid_blocks = 0;
    if (!grid_blocks) {
        int dev = 0, cus = 0, per_cu = 0;
        hipGetDevice(&dev);
        hipDeviceGetAttribute(&cus, hipDeviceAttributeMultiprocessorCount, dev);
        if (hipFuncSetAttribute((const void*)fwd_megakernel, hipFuncAttributeMaxDynamicSharedMemorySize, LDS_BYTES) != hipSuccess) fprintf(stderr, "hipFuncSetAttribute failed\n");
        if (hipOccupancyMaxActiveBlocksPerMultiprocessor(&per_cu, (const void*)fwd_megakernel, NTHR, LDS_BYTES) != hipSuccess || per_cu < 1) { fprintf(stderr, "occupancy query failed\n"); per_cu = 1; }
        if (per_cu > 1) per_cu = 1;
        grid_blocks = cus * per_cu;
    }
    Params p{};
    for (int i = 0; i < 27; ++i) p.in[i] = (const float*)d_in[i];
    p.out = (float*)d_out; p.ws = (unsigned char*)d_ws;
    void* args[] = {&p};
    hipError_t e = hipLaunchCooperativeKernel((const void*)fwd_megakernel, dim3(grid_blocks), dim3(NTHR), args, LDS_BYTES, stream);
    if (e != hipSuccess) fprintf(stderr, "cooperative launch failed: %s (grid %d)\n", hipGetErrorString(e), grid_blocks);
}
```
